# Optimizing an MI355X kernel written in HIP

```python
import jax, jax.numpy as jnp
from jax import lax
import numpy as np

D_MODEL = 1024
BATCH = 8
SEQ = 2048
DEPTH = 2
DEC_BATCH = 128
DEC_SEQ = 8
PAST_LEN = 2048
PAGE_SIZE = 128

N_A = DEPTH // 2
N_B = DEPTH - N_A
MIX_WIDTH = D_MODEL
TOK_WIDTH = MIX_WIDTH // 2
MEM_WIDTH = MIX_WIDTH - TOK_WIDTH
POOL_WINDOWS = (2, 4, 8, 16)
N_POOL_GROUPS = len(POOL_WINDOWS)
POOL_GROUP = TOK_WIDTH // N_POOL_GROUPS
POOL_STATE = max(POOL_WINDOWS) - 1
FOX_HEAD_DIM = 64
FOX_HEADS = TOK_WIDTH // FOX_HEAD_DIM
MEM_HEADS = 4
MEM_HEAD_DIM = MEM_WIDTH // MEM_HEADS
N_MEM = 256
D_FF = -(-8 * D_MODEL // (3 * 256)) * 256
QBLOCK = 128
EPS = 1e-6
FGATE_BIAS = 3.0

kernel_name = "yoco_pool_fox_memory_decoder_step"


def rmsnorm(x, g):
    xf = x.astype(jnp.float32)
    y = xf * lax.rsqrt(jnp.mean(xf * xf, axis=-1, keepdims=True) + EPS)
    return (y * g.astype(jnp.float32)).astype(x.dtype)


def swiglu(x, w_gu, w_down):
    g, u = jnp.split(x @ w_gu, 2, axis=-1)
    return (jax.nn.silu(g) * u) @ w_down


def pool_mix(u_prev, u_new, w_pool, scale):
    B, S, _ = u_new.shape
    P = u_prev.shape[1]
    u_ext = jnp.concatenate([u_prev, u_new], axis=1)
    c = jnp.cumsum(u_ext.astype(jnp.float32), axis=1)
    c = jnp.pad(c, ((0, 0), (1, 0), (0, 0))).reshape(B, P + S + 1, N_POOL_GROUPS, POOL_GROUP)
    hi = P + 1 + jnp.arange(S)
    win = jnp.array(POOL_WINDOWS, dtype=jnp.int32)
    lo = jnp.maximum(hi[:, None] - win[None, :], 0)
    c_hi = c[:, hi]
    c_lo = c[:, lo, jnp.arange(N_POOL_GROUPS)[None, :]]
    count = (hi[:, None] - lo).astype(jnp.float32)[..., None]
    y = (c_hi - c_lo) / count - u_new.reshape(B, S, N_POOL_GROUPS, POOL_GROUP).astype(jnp.float32)
    z = jnp.einsum('bsgc,gcd->bsgd', y.astype(u_new.dtype), w_pool).reshape(B, S, TOK_WIDTH)
    return z * scale, u_ext[:, -POOL_STATE:]


def fox_attention(q, k, v, f_q, f_k, q_pos, k_pos):
    B, Sq, H, Dh = q.shape
    blk = QBLOCK if Sq % QBLOCK == 0 else Sq
    nb = Sq // blk
    scale = Dh ** -0.5
    qb = q.reshape(B, nb, blk, H, Dh).transpose(1, 0, 2, 3, 4)
    fqb = f_q.reshape(B, nb, blk, H).transpose(1, 0, 3, 2)
    pb = q_pos.reshape(nb, blk)
    fk_t = f_k.transpose(0, 2, 1)

    def one_block(args):
        qi, fqi, pi = args
        s = jnp.einsum('bqhd,bkhd->bhqk', qi, k).astype(jnp.float32) * scale
        s = s + (fqi[..., :, None] - fk_t[..., None, :])
        mask = k_pos[None, :] <= pi[:, None]
        p = jax.nn.softmax(jnp.where(mask, s, -jnp.inf), axis=-1)
        return jnp.einsum('bhqk,bkhd->bqhd', p.astype(v.dtype), v)

    out = lax.map(one_block, (qb, fqb, pb))
    return out.transpose(1, 0, 2, 3, 4).reshape(B, Sq, H, Dh)


def mem_attention(q, mk, mv):
    s = jnp.einsum('bqhd,bmhd->bhqm', q, mk).astype(jnp.float32) * (q.shape[-1] ** -0.5)
    p = jax.nn.softmax(s, axis=-1)
    return jnp.einsum('bhqm,bmhd->bqhd', p.astype(mv.dtype), mv)


def memory_kv(mem, g_mem, w_mem_kv, g_mem_k):
    B, M, _ = mem.shape
    k, v = jnp.split(rmsnorm(mem, g_mem) @ w_mem_kv, 2, axis=-1)
    k = rmsnorm(k.reshape(B, M, MEM_HEADS, MEM_HEAD_DIM), g_mem_k)
    return k, v.reshape(B, M, MEM_HEADS, MEM_HEAD_DIM)


def shared_kv(h, g_kv, w_kv, g_fox_k, w_fg, b_fg):
    B, S, _ = h.shape
    hn = rmsnorm(h, g_kv)
    k, v = jnp.split(hn @ w_kv, 2, axis=-1)
    k = rmsnorm(k.reshape(B, S, FOX_HEADS, FOX_HEAD_DIM), g_fox_k)
    v = v.reshape(B, S, FOX_HEADS, FOX_HEAD_DIM)
    logf = jax.nn.log_sigmoid((hn @ w_fg + b_fg).astype(jnp.float32))
    return k, v, logf


def decoder(x, q_pos, pool_prev, mem_k, mem_v, past, g_mix, w_in, w_out, g_ffn, w_gu, w_down,
            g_mem_q, w_pool, pool_scale, g_kv, w_kv, g_fox_k, w_fg, b_fg, g_fox_q):
    B, S, _ = x.shape
    h = x
    pool_states = []
    for l in range(DEPTH):
        z = rmsnorm(h, g_mix[l]) @ w_in[l]
        z_tok, z_mem = z[..., :TOK_WIDTH], z[..., TOK_WIDTH:]
        if l < N_A:
            tok, st = pool_mix(pool_prev[l], z_tok, w_pool[l], pool_scale[l])
            pool_states.append(st)
        else:
            q = rmsnorm(z_tok.reshape(B, S, FOX_HEADS, FOX_HEAD_DIM), g_fox_q[l - N_A])
            tok = fox_attention(q, k_all, v_all, f_q, f_all, q_pos, k_pos).reshape(B, S, TOK_WIDTH)
        qm = rmsnorm(z_mem.reshape(B, S, MEM_HEADS, MEM_HEAD_DIM), g_mem_q[l])
        mo = mem_attention(qm, mem_k[l], mem_v[l]).reshape(B, S, MEM_WIDTH)
        h = h + jnp.concatenate([tok, mo], axis=-1) @ w_out[l]
        h = h + swiglu(rmsnorm(h, g_ffn[l]), w_gu[l], w_down[l])
        if l == N_A - 1:
            k_new, v_new, logf_new = shared_kv(h, g_kv, w_kv, g_fox_k, w_fg, b_fg)
            if past is None:
                k_all, v_all, logf_all = k_new, v_new, logf_new
                k_pos = q_pos
            else:
                k_past, v_past, logf_past = past
                k_all = jnp.concatenate([k_past.astype(k_new.dtype), k_new], axis=1)
                v_all = jnp.concatenate([v_past.astype(v_new.dtype), v_new], axis=1)
                logf_all = jnp.concatenate([logf_past.astype(jnp.float32), logf_new], axis=1)
                k_pos = jnp.arange(k_all.shape[1])
            f_all = jnp.cumsum(logf_all, axis=1)
            f_q = f_all[:, -S:]
    return h, jnp.stack(pool_states), k_new, v_new, logf_new.astype(x.dtype)


def setup_inputs(seed: int = 0) -> dict:
    key = jax.random.key(seed)
    ks = iter(jax.random.split(key, 40))
    nrm = lambda shape, s=1.0: jax.random.normal(next(ks), shape, jnp.float32) * s
    gain = lambda shape: 1.0 + 0.1 * jax.random.normal(next(ks), shape, jnp.float32)
    n_pages = PAST_LEN // PAGE_SIZE
    n_phys = -(-5 * DEC_BATCH * n_pages // 4)
    page_table = jax.random.permutation(next(ks), n_phys)[:DEC_BATCH * n_pages]
    page_table = page_table.reshape(DEC_BATCH, n_pages).astype(jnp.int32)
    return {
        "x_prompt": nrm((BATCH, SEQ, D_MODEL)),
        "x_sample": nrm((DEC_BATCH, DEC_SEQ, D_MODEL)),
        "cache_mem_k": nrm((DEPTH, DEC_BATCH, N_MEM, MEM_HEADS, MEM_HEAD_DIM)),
        "cache_mem_v": nrm((DEPTH, DEC_BATCH, N_MEM, MEM_HEADS, MEM_HEAD_DIM)),
        "state_pool": nrm((N_A, DEC_BATCH, POOL_STATE, TOK_WIDTH)),
        "cache_k": nrm((n_phys, PAGE_SIZE, FOX_HEADS, FOX_HEAD_DIM)),
        "cache_v": nrm((n_phys, PAGE_SIZE, FOX_HEADS, FOX_HEAD_DIM)),
        "cache_logf": jax.nn.log_sigmoid(FGATE_BIAS + nrm((n_phys, PAGE_SIZE, FOX_HEADS))),
        "page_table": page_table,
        "mem_prompt": nrm((BATCH, N_MEM, D_MODEL)),
        "g_mix": gain((DEPTH, D_MODEL)),
        "w_in": nrm((DEPTH, D_MODEL, MIX_WIDTH), D_MODEL ** -0.5),
        "w_out": nrm((DEPTH, MIX_WIDTH, D_MODEL), MIX_WIDTH ** -0.5),
        "g_ffn": gain((DEPTH, D_MODEL)),
        "w_gu": nrm((DEPTH, D_MODEL, 2 * D_FF), D_MODEL ** -0.5),
        "w_down": nrm((DEPTH, D_FF, D_MODEL), D_FF ** -0.5),
        "g_mem": gain((DEPTH, D_MODEL)),
        "w_mem_kv": nrm((DEPTH, D_MODEL, 2 * MEM_WIDTH), D_MODEL ** -0.5),
        "g_mem_q": gain((DEPTH, MEM_HEAD_DIM)),
        "g_mem_k": gain((DEPTH, MEM_HEAD_DIM)),
        "w_pool": nrm((N_A, N_POOL_GROUPS, POOL_GROUP, POOL_GROUP), POOL_GROUP ** -0.5),
        "pool_scale": gain((N_A, TOK_WIDTH)),
        "g_kv": gain((D_MODEL,)),
        "w_kv": nrm((D_MODEL, 2 * TOK_WIDTH), D_MODEL ** -0.5),
        "g_fox_k": gain((FOX_HEAD_DIM,)),
        "w_fg": nrm((D_MODEL, FOX_HEADS), D_MODEL ** -0.5),
        "b_fg": FGATE_BIAS + nrm((FOX_HEADS,), 0.1),
        "g_fox_q": gain((N_B, FOX_HEAD_DIM)),
    }


def reference(x_prompt, x_sample, cache_mem_k, cache_mem_v, state_pool, cache_k, cache_v, cache_logf,
              page_table, mem_prompt, g_mix, w_in, w_out, g_ffn, w_gu, w_down, g_mem, w_mem_kv,
              g_mem_q, g_mem_k, w_pool, pool_scale, g_kv, w_kv, g_fox_k, w_fg, b_fg, g_fox_q):
    weights = (g_mix, w_in, w_out, g_ffn, w_gu, w_down, g_mem_q, w_pool, pool_scale,
               g_kv, w_kv, g_fox_k, w_fg, b_fg, g_fox_q)
    B, S, _ = x_prompt.shape
    mem_kv = [memory_kv(mem_prompt, g_mem[l], w_mem_kv[l], g_mem_k[l]) for l in range(DEPTH)]
    mem_k_prompt = jnp.stack([kv[0] for kv in mem_kv])
    mem_v_prompt = jnp.stack([kv[1] for kv in mem_kv])
    pool_empty = jnp.zeros((N_A, B, 0, TOK_WIDTH), x_prompt.dtype)
    y_prompt, pool_state_prompt, k_p, v_p, logf_p = decoder(
        x_prompt, jnp.arange(S), pool_empty, mem_k_prompt, mem_v_prompt, None, *weights)
    n_pp = S // PAGE_SIZE
    k_rows_prompt = k_p.reshape(B, n_pp, PAGE_SIZE, FOX_HEADS, FOX_HEAD_DIM)
    v_rows_prompt = v_p.reshape(B, n_pp, PAGE_SIZE, FOX_HEADS, FOX_HEAD_DIM)
    logf_rows_prompt = logf_p.reshape(B, n_pp, PAGE_SIZE, FOX_HEADS)
    DB, DS, _ = x_sample.shape
    n_pages = page_table.shape[1]
    past_len = n_pages * PAGE_SIZE

    def gather(c):
        g = c[page_table]
        return g.reshape((DB, past_len) + c.shape[2:])

    past = (gather(cache_k), gather(cache_v), gather(cache_logf))
    y_sample, pool_state_sample, k_rows_sample, v_rows_sample, logf_rows_sample = decoder(
        x_sample, past_len + jnp.arange(DS), state_pool, cache_mem_k, cache_mem_v, past, *weights)
    return (y_prompt, y_sample, k_rows_prompt, v_rows_prompt, logf_rows_prompt, mem_k_prompt,
            mem_v_prompt, pool_state_prompt, k_rows_sample, v_rows_sample, logf_rows_sample,
            pool_state_sample)
```

```cpp
#include <hip/hip_runtime.h>
#include <cstdint>
#include <cstdio>
#include <cmath>
#define MK_DEBUG 0
#define MK_PER_PHASE 0
#define MK_DEBUG_TOL 1e-3
#define MK_DUP 0
#define MK_DUPU 0
#define MK_STREAM_PROBE 0
#define MK_XBAR 0
#define MK_NULLEPI 0
#define MK_DUPS 0
#define MK_TS -1
namespace pg8 {
#define PG8_LAS __attribute__((address_space(3)))
typedef unsigned short bf16_t;
typedef short bf16x8 __attribute__((ext_vector_type(8)));
typedef float f32x4 __attribute__((ext_vector_type(4)));
typedef unsigned u32x4 __attribute__((ext_vector_type(4)));
constexpr int BM = 256, BK = 64, HALF = 128, HTB = HALF * BK * 2  , STAGE_BYTES = 8 * HTB, NXCD = 8, WGM = 8;

__host__ __device__ __forceinline__ int lds_byte(int r, int c) { const int st = (r >> 4) * 2 + (c >> 5), rr = r & 15, cc = c & 31, ob = rr * 64 + cc * 2; return st * 1024 + (ob ^ (((ob >> 9) & 1) << 5)); }
__host__ __device__ __forceinline__ void stage_rc(int b, int& R, int& C) { const int st = b / 1024, sb = b % 1024, swz = sb ^ (((sb >> 9) & 1) << 5); R = (st >> 1) * 16 + swz / 64; C = (st & 1) * 32 + (swz % 64) / 2; }
__host__ __device__ __forceinline__ int perm32(int rho) { const int n = rho >> 4, i = rho & 15; return 8 * (i >> 2) + 4 * n + (i & 3); }

struct Unit { int pm, pn, i; };
struct Gemm { const bf16_t* A; const bf16_t* Bt; int M, N, K; };

struct StaticOrder {
    int nM, nN, nwg, G, c;
    __host__ __device__ void init(int M, int N, int G_, int c_) { nM = M / BM; nN = N / BM; nwg = nM * nN; G = G_; c = c_; }
    __host__ __device__ bool next(int i, Unit& u) const {
        const long L = (long)i * G + c; if (L >= nwg) return false;
        int wgid = (int)L; { const int q = nwg / NXCD, r = nwg % NXCD, xcd = wgid % NXCD, off = wgid / NXCD; wgid = (xcd < r ? xcd * (q + 1) : r * (q + 1) + (xcd - r) * q) + off; }
        const int nig = WGM * nN, gid = wgid / nig, fm = gid * WGM, gsz = (nM - fm) < WGM ? (nM - fm) : WGM;
        u.pm = fm + ((wgid % nig) % gsz); u.pn = (wgid % nig) / gsz; u.i = i; return true;
    }
    __device__ __forceinline__ void a_ready(const Unit&) const {}
    __device__ __forceinline__ void done(const Unit&) const {}
};

__device__ __forceinline__ unsigned cvt_pk_bf16(float lo, float hi) { unsigned r; asm volatile("v_cvt_pk_bf16_f32 %0, %1, %2" : "=v"(r) : "v"(lo), "v"(hi)); return r; }
typedef float f32x2 __attribute__((ext_vector_type(2)));
template <class Epi, class Sched, bool ALIGN_EPI = false, bool SP2 = false>
__device__ __forceinline__ void gemm_phase(PG8_LAS unsigned char* lds, const Gemm g, const Sched& S, const Epi& E) {
    int tid = threadIdx.x; asm volatile("" : "+v"(tid));
    const int wid = __builtin_amdgcn_readfirstlane(tid >> 6), lane = tid & 63, wr = wid >> 2, wc = wid & 3, fr = lane & 15, fq = lane >> 4;
    const int K = g.K, nt = K / BK;
    unsigned voffA[2], voffB[2];
#pragma unroll
    for (int i = 0; i < 2; ++i) { int R, C; stage_rc(tid * 16 + i * 8192, R, C); const int Rb = Epi::PERM ? ((R & ~31) + perm32(R & 31)) : R;
        voffA[i] = (unsigned)(R * K + C) * 2u; voffB[i] = (unsigned)(Rb * K + C) * 2u; }
    const size_t kstep = (size_t)(BK * 2);
    const size_t hstep = (size_t)HALF * K * 2;
    const size_t tstep = 2 * hstep;
    const unsigned ldsw = (unsigned)wid * 1024u;
    const int aoff = lds_byte(wr * 64 + fr, fq * 8), boff = lds_byte(wc * 32 + fr, fq * 8);
#define PG8_SA(b, h) (((b) * 2 + (h)) * HTB)
#define PG8_SB(b, h) ((4 + (b) * 2 + (h)) * HTB)
#define PG8_STAGE(bufoff, gbase, voff) do { _Pragma("unroll") for (int _i = 0; _i < 2; ++_i) \
        __builtin_amdgcn_global_load_lds((const unsigned*)((const char*)(gbase) + (voff)[_i]), (PG8_LAS unsigned*)(lds + (bufoff) + ldsw + _i * 8192), 16, 0, 0); } while (0)
#define PG8_LDA(dst, b, h) do { _Pragma("unroll") for (int m = 0; m < 4; ++m) _Pragma("unroll") for (int k = 0; k < 2; ++k) dst[m][k] = *(const PG8_LAS bf16x8*)(lds + PG8_SA(b, h) + aoff + m * 2048 + k * 1024); } while (0)
#define PG8_LDB(dst, b, h) do { _Pragma("unroll") for (int n = 0; n < 2; ++n) _Pragma("unroll") for (int k = 0; k < 2; ++k) dst[n][k] = *(const PG8_LAS bf16x8*)(lds + PG8_SB(b, h) + boff + n * 2048 + k * 1024); } while (0)
#define PG8_MMA(ai, bj, At, Bt) do { __builtin_amdgcn_s_setprio(1); _Pragma("unroll") for (int m = 0; m < 4; ++m) _Pragma("unroll") for (int n = 0; n < 2; ++n) _Pragma("unroll") for (int k = 0; k < 2; ++k) \
        acc[ai][bj][m][n] = __builtin_amdgcn_mfma_f32_16x16x32_bf16(Bt[n][k], At[m][k], acc[ai][bj][m][n], 0, 0, 0); __builtin_amdgcn_s_setprio(0); } while (0)
#define PG8_WAIT_V(n) asm volatile("s_waitcnt vmcnt(" #n ")" ::: "memory")
#define PG8_WAIT_L(n) asm volatile("s_waitcnt lgkmcnt(" #n ")" ::: "memory")
#define PG8_BAR __builtin_amdgcn_s_barrier()
#define PG8_SCHED __builtin_amdgcn_sched_barrier(0)
    Unit cur, nxt; int ui = 0;
    if (!S.next(0, cur)) return;
    f32x4 acc[2][2][4][2];
#pragma unroll
    for (int a = 0; a < 2; ++a)
#pragma unroll
        for (int b = 0; b < 2; ++b)
#pragma unroll
            for (int m = 0; m < 4; ++m)
#pragma unroll
                for (int n = 0; n < 2; ++n) acc[a][b][m][n] = (f32x4){0.f, 0.f, 0.f, 0.f};
    bf16x8 At[4][2], B0[2][2], B1[2][2];
    const char* cA = (const char*)g.A + (size_t)cur.pm * tstep; const char* cB = (const char*)g.Bt + (size_t)cur.pn * tstep;
    S.a_ready(cur);
    if constexpr (SP2) {
        PG8_STAGE(PG8_SB(0, 0), cB, voffB); PG8_STAGE(PG8_SB(0, 1), cB + hstep, voffB); PG8_STAGE(PG8_SA(0, 0), cA, voffA); PG8_STAGE(PG8_SA(0, 1), cA + hstep, voffA);
        if (wr == 1) PG8_BAR;
        PG8_WAIT_V(2); PG8_BAR;
        PG8_STAGE(PG8_SB(1, 0), cB + kstep, voffB); PG8_STAGE(PG8_SA(1, 0), cA + kstep, voffA); PG8_STAGE(PG8_SB(1, 1), cB + hstep + kstep, voffB);
        PG8_WAIT_V(6); PG8_BAR;
    } else {
        PG8_STAGE(PG8_SB(0, 0), cB, voffB); PG8_STAGE(PG8_SA(0, 0), cA, voffA); PG8_STAGE(PG8_SB(0, 1), cB + hstep, voffB); PG8_STAGE(PG8_SA(0, 1), cA + hstep, voffA);
        if (wr == 1) PG8_BAR;
        PG8_WAIT_V(4); PG8_BAR;
        PG8_STAGE(PG8_SB(1, 0), cB + kstep, voffB); PG8_STAGE(PG8_SA(1, 0), cA + kstep, voffA); PG8_STAGE(PG8_SB(1, 1), cB + hstep + kstep, voffB);
        PG8_WAIT_V(6); PG8_BAR;
    }
    for (;;) {
        const bool has_next = S.next(ui + 1, nxt);
        const char* nA = has_next ? (const char*)g.A + (size_t)nxt.pm * tstep : cA; const char* nB = has_next ? (const char*)g.Bt + (size_t)nxt.pn * tstep : cB;
        for (int t = 0; t < nt; t += 2) {
            const bool last = (t == nt - 2);
            const char* a1 = cA + (size_t)(t + 1) * kstep;
            const char* a2 = last ? nA : cA + (size_t)(t + 2) * kstep; const char* b2 = last ? nB : cB + (size_t)(t + 2) * kstep;
            const char* a3 = a2 + kstep; const char* b3 = b2 + kstep;
            if (last && has_next) S.a_ready(nxt);
            if constexpr (SP2) {
            PG8_LDB(B0, 0, 0); PG8_LDB(B1, 0, 1); PG8_SCHED; PG8_LDA(At, 0, 0); PG8_STAGE(PG8_SA(1, 1), a1 + hstep, voffA);
            PG8_WAIT_V(8); PG8_WAIT_L(0); PG8_BAR; PG8_MMA(0, 0, At, B0); PG8_MMA(0, 1, At, B1); PG8_BAR; PG8_SCHED;
            PG8_LDA(At, 0, 1); PG8_STAGE(PG8_SB(0, 0), b2, voffB); PG8_STAGE(PG8_SB(0, 1), b2 + hstep, voffB); PG8_STAGE(PG8_SA(0, 0), a2, voffA);
            PG8_WAIT_V(8); PG8_WAIT_L(0); PG8_BAR; PG8_MMA(1, 0, At, B0); PG8_MMA(1, 1, At, B1); PG8_BAR; PG8_SCHED;
            PG8_LDB(B0, 1, 0); PG8_LDB(B1, 1, 1); PG8_SCHED; PG8_LDA(At, 1, 0); PG8_STAGE(PG8_SA(0, 1), a2 + hstep, voffA);
            PG8_WAIT_V(8); PG8_WAIT_L(0); PG8_BAR; PG8_MMA(0, 0, At, B0); PG8_MMA(0, 1, At, B1); PG8_BAR; PG8_SCHED;
            PG8_LDA(At, 1, 1); PG8_STAGE(PG8_SB(1, 0), b3, voffB); PG8_STAGE(PG8_SB(1, 1), b3 + hstep, voffB); PG8_STAGE(PG8_SA(1, 0), a3, voffA);
            PG8_WAIT_V(8); PG8_WAIT_L(0); PG8_BAR; PG8_MMA(1, 0, At, B0); PG8_MMA(1, 1, At, B1); PG8_BAR; PG8_SCHED;
            } else {
            PG8_LDB(B0, 0, 0); PG8_SCHED; PG8_LDA(At, 0, 0); PG8_STAGE(PG8_SA(1, 1), a1 + hstep, voffA);
            PG8_WAIT_L(8); PG8_BAR; PG8_WAIT_L(0); PG8_MMA(0, 0, At, B0); PG8_BAR; PG8_SCHED;
            PG8_LDB(B1, 0, 1); PG8_STAGE(PG8_SB(0, 0), b2, voffB);
            PG8_BAR; PG8_WAIT_L(0); PG8_MMA(0, 1, At, B1); PG8_BAR;
            PG8_LDA(At, 0, 1); PG8_STAGE(PG8_SA(0, 0), a2, voffA);
            PG8_BAR; PG8_WAIT_L(0); PG8_MMA(1, 0, At, B0); PG8_BAR; PG8_SCHED;
            PG8_STAGE(PG8_SB(0, 1), b2 + hstep, voffB);
            PG8_WAIT_V(6); PG8_BAR; PG8_MMA(1, 1, At, B1); PG8_BAR;
            PG8_LDB(B0, 1, 0); PG8_SCHED; PG8_LDA(At, 1, 0); PG8_STAGE(PG8_SA(0, 1), a2 + hstep, voffA);
            PG8_WAIT_L(8); PG8_BAR; PG8_WAIT_L(0); PG8_MMA(0, 0, At, B0); PG8_BAR; PG8_SCHED;
            PG8_LDB(B1, 1, 1); PG8_STAGE(PG8_SB(1, 0), b3, voffB);
            PG8_BAR; PG8_WAIT_L(0); PG8_MMA(0, 1, At, B1); PG8_BAR;
            PG8_LDA(At, 1, 1); PG8_STAGE(PG8_SA(1, 0), a3, voffA);
            PG8_BAR; PG8_WAIT_L(0); PG8_MMA(1, 0, At, B0); PG8_BAR; PG8_SCHED;
            PG8_STAGE(PG8_SB(1, 1), b3 + hstep, voffB);
            PG8_WAIT_V(6); PG8_BAR; PG8_MMA(1, 1, At, B1); PG8_BAR;
            }
        }
        if constexpr (ALIGN_EPI) { if (wr == 0) PG8_BAR; }
        if constexpr (!Epi::AFTER_DRAIN) { E(acc, cur, wr, wc, fr, fq); S.done(cur); }
        if (!has_next) break;
#pragma unroll
        for (int a = 0; a < 2; ++a)
#pragma unroll
            for (int b = 0; b < 2; ++b)
#pragma unroll
                for (int m = 0; m < 4; ++m)
#pragma unroll
                    for (int n = 0; n < 2; ++n) acc[a][b][m][n] = (f32x4){0.f, 0.f, 0.f, 0.f};
        cur = nxt; cA = nA; cB = nB; ++ui;
        if constexpr (ALIGN_EPI) { if (wr == 1) PG8_BAR; }
    }
    PG8_WAIT_V(0);
    if constexpr (!ALIGN_EPI) { if (wr == 0) PG8_BAR; }
    PG8_BAR;
    if constexpr (Epi::AFTER_DRAIN) { E.fused(acc, cur, wr, wc, fr, fq, lds, wid, lane); S.done(cur); }
#undef PG8_SA
#undef PG8_SB
#undef PG8_STAGE
#undef PG8_LDA
#undef PG8_LDB
#undef PG8_MMA
#undef PG8_WAIT_V
#undef PG8_WAIT_L
#undef PG8_BAR
#undef PG8_SCHED
}
}
#define GAS __attribute__((address_space(1)))
#define LAS __attribute__((address_space(3)))
typedef unsigned short bf16;
typedef unsigned v4u __attribute__((ext_vector_type(4)));
typedef unsigned v2u __attribute__((ext_vector_type(2)));
typedef float f32x4 __attribute__((ext_vector_type(4)));
typedef float f32x16 __attribute__((ext_vector_type(16)));
typedef short bf16x8 __attribute__((ext_vector_type(8)));
typedef GAS unsigned gu32;
#define RLX_AGENT __ATOMIC_RELAXED, __HIP_MEMORY_SCOPE_AGENT
#define LDS_WAIT() asm volatile("s_waitcnt lgkmcnt(0)" ::: "memory")
#define VM_WAIT() asm volatile("s_waitcnt vmcnt(0)" ::: "memory")
__device__ __forceinline__ unsigned f2bf(float f) { unsigned u = __builtin_bit_cast(unsigned, f); return (u + 0x7fffu + ((u >> 16) & 1u)) >> 16; }
typedef float f32x2_t __attribute__((ext_vector_type(2))); typedef __bf16 bf16x2_t __attribute__((ext_vector_type(2)));
__device__ __forceinline__ unsigned pk2(float lo, float hi) { f32x2_t v = {lo, hi}; bf16x2_t b = __builtin_convertvector(v, bf16x2_t); return __builtin_bit_cast(unsigned, b); }
__device__ __forceinline__ float bf_lo(unsigned w) { return __builtin_bit_cast(float, w << 16); }
__device__ __forceinline__ float bf_hi(unsigned w) { return __builtin_bit_cast(float, w & 0xffff0000u); }

constexpr int D = 1024, PB = 8, PS = 2048, SB = 128, SS = 8, MP = PB * PS, MS = SB * SS, M = MP + MS;
constexpr int TOKW = 512, NMEM = 256, FF = 2816, NPAGES = 16, PAGE = 128, PAST = 2048;
constexpr int MEMROWS = PB * NMEM;
constexpr float EPS = 1e-6f, LOG2E = 1.4426950408889634f;
constexpr int NWAVES = 8;

constexpr int RING_BYTES = 131072;
constexpr int LDS_BYTES = 163840;
constexpr int LCTL_OFF = LDS_BYTES - 1024;
constexpr int EPX_OFF = RING_BYTES;

constexpr size_t MiB = 1u << 20;
constexpr size_t al(size_t x) { return (x + 4095) & ~(size_t)4095; }
constexpr size_t F_CTL = 0, CTL_ZERO_BYTES = 1 * MiB;
constexpr size_t F_WIN0 = F_CTL + CTL_ZERO_BYTES;
constexpr size_t F_W6 = F_WIN0 + al((size_t)D * D * 2);
constexpr size_t F_WOUT = F_W6 + al((size_t)2 * D * D * 2);
constexpr size_t F_WGU = F_WOUT + al((size_t)2 * D * D * 2);
constexpr size_t F_WDOWN = F_WGU + al((size_t)2 * 2 * FF * D * 2);
constexpr size_t F_WMEM = F_WDOWN + al((size_t)2 * D * FF * 2);
constexpr size_t F_WPOOL = F_WMEM + al((size_t)2 * D * D * 2);
constexpr size_t F_WFG = F_WPOOL + al((size_t)4 * 128 * 128 * 2);
constexpr size_t F_XB = F_WFG + al((size_t)8 * D * 4);
constexpr size_t F_MEMB = F_XB + al((size_t)M * D * 2);
constexpr size_t F_ZB = F_MEMB + al((size_t)MEMROWS * D * 2);
constexpr size_t F_Z1B = F_ZB + al((size_t)M * D * 2);
constexpr size_t F_MIXB = F_Z1B + al((size_t)M * D * 2);
constexpr size_t F_HB = F_MIXB + al((size_t)2 * M * D * 2);
constexpr size_t F_HF = F_HB + al((size_t)4 * M * D * 2);
constexpr size_t F_ACTB = F_HF + al((size_t)3 * M * D * 4);
constexpr size_t F_KB = F_ACTB + al((size_t)2 * M * FF * 2);
constexpr size_t F_VB = F_KB + al((size_t)M * TOKW * 2);
constexpr size_t F_MKB = F_VB + al((size_t)M * TOKW * 2);
constexpr size_t F_MVB = F_MKB + al((size_t)2 * MEMROWS * TOKW * 2);
constexpr size_t F_SS0 = F_MVB + al((size_t)2 * MEMROWS * TOKW * 2);
constexpr size_t F_SSM = F_SS0 + al((size_t)M * 4);
constexpr size_t F_SSH = F_SSM + al((size_t)MEMROWS * 4);
constexpr size_t F_END = F_SSH + al((size_t)3 * M * 16 * 4);
constexpr int CW_BAR = 4096;
constexpr int CW_Q = 16384;
constexpr int CW_PANEL = 32768;
constexpr int CW_SDONE = CW_PANEL + 64 * 64;
constexpr int CW_TMO = 8;
static_assert((size_t)(CW_SDONE + 64) * 4 <= CTL_ZERO_BYTES, "control words inside the zeroed region");

struct Args {
    const float* in[28]; float* out; unsigned char* ws; int ph_lo, ph_hi;
};
struct OutPtrs { float *y_p, *y_s, *k_p, *v_p, *lf_p, *mk_p, *mv_p, *ps_p, *k_s, *v_s, *lf_s, *ps_s; };
__host__ __device__ __forceinline__ OutPtrs carve_out(float* o) {
    OutPtrs r; size_t p = 0;
    r.y_p = o + p; p += (size_t)MP * D; r.y_s = o + p; p += (size_t)MS * D;
    r.k_p = o + p; p += (size_t)MP * TOKW; r.v_p = o + p; p += (size_t)MP * TOKW; r.lf_p = o + p; p += (size_t)MP * 8;
    r.mk_p = o + p; p += (size_t)2 * MEMROWS * TOKW; r.mv_p = o + p; p += (size_t)2 * MEMROWS * TOKW; r.ps_p = o + p; p += (size_t)PB * 15 * TOKW;
    r.k_s = o + p; p += (size_t)MS * TOKW; r.v_s = o + p; p += (size_t)MS * TOKW; r.lf_s = o + p; p += (size_t)MS * 8; r.ps_s = o + p; p += (size_t)SB * 15 * TOKW;
    return r;
}

__device__ __forceinline__ float row_rstd(const float* ss, int nparts, int row) {
    float s;
    if (nparts == 1) s = ss[row];
    else { const f32x4* p = (const f32x4*)(ss + (size_t)row * 16); const f32x4 a = p[0], b = p[1], c = p[2], d = p[3];
        s = ((a.x + a.y) + (a.z + a.w)) + ((b.x + b.y) + (b.z + b.w)) + ((c.x + c.y) + (c.z + c.w)) + ((d.x + d.y) + (d.z + d.w)); }
    return 1.0f / sqrtf(s * (1.0f / D) + EPS);
}

constexpr int RT_OFF = RING_BYTES;
template <class Sched> __device__ __forceinline__ void fill_rstd_table(LAS unsigned char* lds, const Sched& S, const float* ss, int nparts, int tid) {
    LAS float* rt = (LAS float*)(lds + RT_OFF); pg8::Unit u;
    for (int i = 0; i < 8 && S.next(i, u); ++i) if (tid < 256) rt[i * 256 + tid] = row_rstd(ss, nparts, u.pm * 256 + tid);
    __syncthreads();
}
namespace epi {
using pg8::Unit; using pg8::f32x4; using pg8::BM; using pg8::HALF;
struct ScaleBf16 {
    static constexpr bool PERM = true, AFTER_DRAIN = false;
    bf16* O; int ldc; const LAS float* rt;
    __device__ __forceinline__ void operator()(const f32x4 (&acc)[2][2][4][2], const Unit& u, int wr, int wc, int fr, int fq) const {
        const int row0 = u.pm * BM + wr * 64 + fr, col0 = u.pn * BM + wc * 32 + 8 * fq; const LAS float* rtu = rt + u.i * 256 + wr * 64 + fr;
#pragma unroll
        for (int ai = 0; ai < 2; ++ai)
#pragma unroll
            for (int m = 0; m < 4; ++m) { const int row = row0 + ai * HALF + m * 16; const float rs = rtu[ai * HALF + m * 16]; bf16* rowp = O + (size_t)row * ldc + col0;
#pragma unroll
                for (int bj = 0; bj < 2; ++bj) { const f32x4 v0 = acc[ai][bj][m][0] * rs, v1 = acc[ai][bj][m][1] * rs;
                    v4u w; w.x = pk2(v0[0], v0[1]); w.y = pk2(v0[2], v0[3]); w.z = pk2(v1[0], v1[1]); w.w = pk2(v1[2], v1[3]);
                    *(v4u*)(rowp + bj * HALF) = w; } }
    }
};
struct MemKV {
    static constexpr bool PERM = true, AFTER_DRAIN = false;
    bf16* MKB; bf16* MVB; float* mv_out; const LAS float* rt; int lbase;
    __device__ __forceinline__ void operator()(const f32x4 (&acc)[2][2][4][2], const Unit& u, int wr, int wc, int fr, int fq) const {
        const int row0 = u.pm * BM + wr * 64 + fr; const int l = lbase + (u.pn >> 2); const bool isv = (u.pn & 2) != 0;
        const int c0 = (u.pn & 1) * BM + wc * 32 + 8 * fq;
        const LAS float* rtu = rt + u.i * 256 + wr * 64 + fr;
#pragma unroll
        for (int ai = 0; ai < 2; ++ai)
#pragma unroll
            for (int m = 0; m < 4; ++m) { const int row = row0 + ai * HALF + m * 16; const float rs = rtu[ai * HALF + m * 16];
                const size_t off = ((size_t)l * MEMROWS + row) * TOKW + c0;
#pragma unroll
                for (int bj = 0; bj < 2; ++bj) { const f32x4 v0 = acc[ai][bj][m][0] * rs, v1 = acc[ai][bj][m][1] * rs;
                    v4u w; w.x = pk2(v0[0], v0[1]); w.y = pk2(v0[2], v0[3]); w.z = pk2(v1[0], v1[1]); w.w = pk2(v1[2], v1[3]);
                    if (isv) { *(v4u*)(MVB + off + bj * HALF) = w; *(f32x4*)(mv_out + off + bj * HALF) = v0; *(f32x4*)(mv_out + off + bj * HALF + 4) = v1; }
                    else *(v4u*)(MKB + off + bj * HALF) = w; } }
    }
};
struct Resid {
    static constexpr bool PERM = true, AFTER_DRAIN = false;
    const bf16* hin; bf16* HB; float* y32; float* ssout;
    __device__ __forceinline__ void operator()(const f32x4 (&acc)[2][2][4][2], const Unit& u, int wr, int wc, int fr, int fq) const {
        const int row0 = u.pm * BM + wr * 64 + fr, col0 = u.pn * BM + wc * 32 + 8 * fq;
#pragma unroll
        for (int ai = 0; ai < 2; ++ai)
#pragma unroll
            for (int m = 0; m < 4; ++m) { const int row = row0 + ai * HALF + m * 16; const size_t off = (size_t)row * D + col0; float s = 0.f;
#pragma unroll
                for (int bj = 0; bj < 2; ++bj) {
                    const v4u r = *(const v4u*)(hin + off + bj * HALF);
                    const f32x4 v0 = acc[ai][bj][m][0] + (f32x4){bf_lo(r.x), bf_hi(r.x), bf_lo(r.y), bf_hi(r.y)}, v1 = acc[ai][bj][m][1] + (f32x4){bf_lo(r.z), bf_hi(r.z), bf_lo(r.w), bf_hi(r.w)};
                    if (y32) { *(f32x4*)(y32 + off + bj * HALF) = v0; *(f32x4*)(y32 + off + bj * HALF + 4) = v1; }
                    if (HB) { v4u w; w.x = pk2(v0[0], v0[1]); w.y = pk2(v0[2], v0[3]); w.z = pk2(v1[0], v1[1]); w.w = pk2(v1[2], v1[3]); *(v4u*)(HB + off + bj * HALF) = w; }
                    s += (v0[0] * v0[0] + v0[1] * v0[1]) + (v0[2] * v0[2] + v0[3] * v0[3]) + (v1[0] * v1[0] + v1[1] * v1[1]) + (v1[2] * v1[2] + v1[3] * v1[3]); }
                if (ssout) { s += __shfl_xor(s, 16); s += __shfl_xor(s, 32); if (fq == 0) ssout[(size_t)row * 16 + u.pn * 4 + wc] = s; } }
    }
};
struct Swiglu {
    static constexpr bool PERM = true, AFTER_DRAIN = false;
    bf16* ACT; const LAS float* rt;
    __device__ __forceinline__ void operator()(const f32x4 (&acc)[2][2][4][2], const Unit& u, int wr, int wc, int fr, int fq) const {
        const int row0 = u.pm * BM + wr * 64 + fr, col0 = u.pn * 128 + wc * 32 + 8 * fq; const LAS float* rtu = rt + u.i * 256 + wr * 64 + fr;
#pragma unroll
        for (int ai = 0; ai < 2; ++ai)
#pragma unroll
            for (int m = 0; m < 4; ++m) { const int row = row0 + ai * HALF + m * 16; const float rs = rtu[ai * HALF + m * 16];
                float a[8];
#pragma unroll
                for (int bj = 0; bj < 2; ++bj) { const f32x4 g = acc[ai][bj][m][0] * rs, uu = acc[ai][bj][m][1] * rs;
#pragma unroll
                    for (int i = 0; i < 4; ++i) a[bj * 4 + i] = g[i] * __builtin_amdgcn_rcpf(1.0f + __builtin_amdgcn_exp2f(-g[i] * LOG2E)) * uu[i]; }
                v4u w; w.x = pk2(a[0], a[1]); w.y = pk2(a[2], a[3]); w.z = pk2(a[4], a[5]); w.w = pk2(a[6], a[7]);
                *(v4u*)(ACT + (size_t)row * FF + col0) = w; }
    }
};
struct KVQ {
    static constexpr bool PERM = true, AFTER_DRAIN = false;
    bf16* KB; bf16* VB; bf16* Z1B; float* k_p; float* k_s; float* v_p; float* v_s; const float* g_fox_k; const LAS float* rt;
    __device__ __forceinline__ void operator()(const f32x4 (&acc)[2][2][4][2], const Unit& u, int wr, int wc, int fr, int fq) const {
        const int row0 = u.pm * BM + wr * 64 + fr; const int kind = u.pn >> 1;
        const LAS float* rtu = rt + u.i * 256 + wr * 64 + fr;
        const int c0 = (u.pn & 1) * BM + wc * 64 + 8 * fq;
        f32x4 gk[2][2];
#pragma unroll
        for (int bj = 0; bj < 2; ++bj)
#pragma unroll
            for (int n = 0; n < 2; ++n) gk[bj][n] = (kind == 0) ? *(const LAS f32x4*)(rt + 2048 + 32 * bj + 8 * fq + 4 * n) : (f32x4){1.f, 1.f, 1.f, 1.f};
#pragma unroll
        for (int ai = 0; ai < 2; ++ai)
#pragma unroll
            for (int m = 0; m < 4; ++m) { const int row = row0 + ai * HALF + m * 16; const float rs = rtu[ai * HALF + m * 16];
                f32x4 v[2][2]; float s = 0.f;
#pragma unroll
                for (int bj = 0; bj < 2; ++bj)
#pragma unroll
                    for (int n = 0; n < 2; ++n) { v[bj][n] = acc[ai][bj][m][n] * rs; s += (v[bj][n][0] * v[bj][n][0] + v[bj][n][1] * v[bj][n][1]) + (v[bj][n][2] * v[bj][n][2] + v[bj][n][3] * v[bj][n][3]); }
                if (kind == 0) { s += __shfl_xor(s, 16); s += __shfl_xor(s, 32); const float rk = 1.0f / sqrtf(s * (1.0f / 64.0f) + EPS);
#pragma unroll
                    for (int bj = 0; bj < 2; ++bj)
#pragma unroll
                        for (int n = 0; n < 2; ++n) v[bj][n] = v[bj][n] * rk * gk[bj][n]; }
                if (kind <= 1) {
                    const bool smp = row >= MP; float* o32 = (kind == 0) ? (smp ? k_s + (size_t)(row - MP) * TOKW : k_p + (size_t)row * TOKW) : (smp ? v_s + (size_t)(row - MP) * TOKW : v_p + (size_t)row * TOKW);
                    bf16* o16 = (kind == 0 ? KB : VB) + (size_t)row * TOKW;
#pragma unroll
                    for (int bj = 0; bj < 2; ++bj) { const int c = c0 + 32 * bj;
                        *(f32x4*)(o32 + c) = v[bj][0]; *(f32x4*)(o32 + c + 4) = v[bj][1];
                        v4u w; w.x = pk2(v[bj][0][0], v[bj][0][1]); w.y = pk2(v[bj][0][2], v[bj][0][3]); w.z = pk2(v[bj][1][0], v[bj][1][1]); w.w = pk2(v[bj][1][2], v[bj][1][3]);
                        *(v4u*)(o16 + c) = w; }
                } else {
                    bf16* o16 = Z1B + (size_t)row * D + (u.pn - 4) * BM + wc * 64 + 8 * fq;
#pragma unroll
                    for (int bj = 0; bj < 2; ++bj) { v4u w; w.x = pk2(v[bj][0][0], v[bj][0][1]); w.y = pk2(v[bj][0][2], v[bj][0][3]); w.z = pk2(v[bj][1][0], v[bj][1][1]); w.w = pk2(v[bj][1][2], v[bj][1][3]);
                        *(v4u*)(o16 + 32 * bj) = w; }
                }
                if (m & 1) asm volatile("" ::: "memory"); }
    }
};
struct Null {
    static constexpr bool PERM = true, AFTER_DRAIN = false;
    float* sink;
    __device__ __forceinline__ void operator()(const f32x4 (&acc)[2][2][4][2], const Unit& u, int wr, int wc, int fr, int fq) const {
        f32x4 s = {0.f, 0.f, 0.f, 0.f};
#pragma unroll
        for (int ai = 0; ai < 2; ++ai)
#pragma unroll
            for (int bj = 0; bj < 2; ++bj)
#pragma unroll
                for (int m = 0; m < 4; ++m) s += acc[ai][bj][m][0] + acc[ai][bj][m][1];
        if (s[0] + s[1] + s[2] + s[3] == 1.2345e33f) sink[0] = 1.f;
    }
};
}
#define XB_TMO      128
#define XB_XCNT(j)  (256  + 64 * (j))
#define XB_XSUB(j)  (1280 + 64 * (j))
#define XB_XGEN(j)  (2304 + 64 * (j))
#define XB_TOP      3328
#define XB_TOPGEN   3392
#define XCD_BAR_WORDS 3456
#define XB_SPIN_CAP (1u << 18)

__device__ __forceinline__ unsigned xb_ld(unsigned* p)              { return __hip_atomic_load(p, __ATOMIC_RELAXED, __HIP_MEMORY_SCOPE_AGENT); }
__device__ __forceinline__ unsigned xb_add(unsigned* p, unsigned v) { return __hip_atomic_fetch_add(p, v, __ATOMIC_RELAXED, __HIP_MEMORY_SCOPE_AGENT); }
__device__ __forceinline__ unsigned xb_xcc_id() { return (unsigned)__builtin_amdgcn_s_getreg((3 << 11) | 20) & 0xFu; }
#define XB_SPIN(cond, bar) do { unsigned _sp = 0; while (cond) { __builtin_amdgcn_s_sleep(1); \
    if ((++_sp & 255u) == 0u) { if (xb_ld(&(bar)[XB_TMO])) break; if (_sp > XB_SPIN_CAP) { atomicAdd(&(bar)[XB_TMO], 1u); break; } } } } while (0)

struct XcdBarrier {
    unsigned* bar; unsigned x;
    volatile LAS unsigned* st;
};

__device__ __forceinline__ XcdBarrier xcd_barrier_post(unsigned* bar, volatile LAS unsigned* st) {
    XcdBarrier b; b.bar = bar; b.x = xb_xcc_id(); b.st = st;
    if (threadIdx.x == 0) (void)xb_add(&bar[XB_XCNT(b.x)], 1u);
    return b;
}
__device__ __forceinline__ void xcd_barrier_complete(unsigned* bar, unsigned x, unsigned& nloc, unsigned& nx) {
    const unsigned G = gridDim.x * gridDim.y * gridDim.z;
    unsigned sum, cnt, mine, sp = 0u;
    for (;;) {
        sum = 0u; cnt = 0u; mine = 0u;
#pragma unroll
        for (unsigned j = 0; j < 16; ++j) { const unsigned c = xb_ld(&bar[XB_XCNT(j)]); sum += c; cnt += (c > 0u) ? 1u : 0u; mine = (j == x) ? c : mine; }
        if (sum == G) break;
        __builtin_amdgcn_s_sleep(1);
        if ((++sp & 255u) == 0u) { if (xb_ld(&bar[XB_TMO])) break; if (sp > XB_SPIN_CAP) { atomicAdd(&bar[XB_TMO], 1u); break; } }
    }
    nloc = mine > 0u ? mine : 1u; nx = cnt > 0u ? cnt : 1u;
}

__device__ __forceinline__ void xcd_barrier(const XcdBarrier& b) {
    asm volatile("s_waitcnt vmcnt(0)" ::: "memory");
    __syncthreads();
    if (threadIdx.x == 0) {
        unsigned* bar = b.bar;
        __builtin_amdgcn_s_waitcnt(0);
        asm volatile("buffer_wbl2 sc1" ::: "memory");
        unsigned nloc = b.st[0], nx = b.st[1];
        if (nloc == 0u) { xcd_barrier_complete(bar, b.x, nloc, nx); b.st[0] = nloc; b.st[1] = nx; }
        const unsigned old = xb_add(&bar[XB_XSUB(b.x)], 1u);
        const unsigned gen = old / nloc;
        if (old + 1u == (gen + 1u) * nloc) {
            __builtin_amdgcn_fence(__ATOMIC_RELEASE, "agent");
            asm volatile("s_waitcnt vmcnt(0)" ::: "memory");
            const unsigned og = xb_add(&bar[XB_TOP], 1u);
            const unsigned tg = og / nx;
            if (og + 1u == (tg + 1u) * nx) xb_add(&bar[XB_TOPGEN], 1u);
            else XB_SPIN(xb_ld(&bar[XB_TOPGEN]) == tg, bar);
            __builtin_amdgcn_fence(__ATOMIC_ACQUIRE, "agent");
            xb_add(&bar[XB_XGEN(b.x)], 1u);
            asm volatile("s_waitcnt vmcnt(0)" ::: "memory");
        } else {
            XB_SPIN(xb_ld(&bar[XB_XGEN(b.x)]) == gen, bar);
            __builtin_amdgcn_fence(__ATOMIC_ACQUIRE, "agent");
            asm volatile("s_waitcnt vmcnt(0)" ::: "memory");
        }
    }
    __syncthreads();
}
struct Frame {
    LAS unsigned char* lds;
    volatile LAS unsigned* MISC;
    gu32* ctl;
    int tid, lane, wave, G;
    unsigned char* ws;
    const float* in[28];
    OutPtrs O;
};
__device__ __forceinline__ float wave_sum(float v) {
#pragma unroll
    for (int o = 1; o < 64; o <<= 1) v += __shfl_xor(v, o);
    return v;
}
struct QState { unsigned nxt; int par; };
__device__ __forceinline__ unsigned q_take(Frame& F, int q) { return __hip_atomic_fetch_add((unsigned*)(F.ctl + CW_Q + 64 * q), 1u, __ATOMIC_RELAXED, __HIP_MEMORY_SCOPE_AGENT); }
__device__ __forceinline__ int q_first(Frame& F, int q, QState& st) {
    __syncthreads();
    if (F.tid == 0) F.MISC[0] = q_take(F, q);
    __syncthreads();
    st.par = 1; st.nxt = 0u; return (int)F.MISC[0];
}
__device__ __forceinline__ void q_prefetch(Frame& F, int q, QState& st) { if (F.tid == 0) st.nxt = q_take(F, q); }
__device__ __forceinline__ int q_advance(Frame& F, QState& st) {
    if (F.tid == 0) F.MISC[st.par] = st.nxt;
    __syncthreads();
    const int u = (int)F.MISC[st.par]; st.par ^= 1; return u;
}

enum { MAP_ID = 0, MAP_SWIGLU = 1, MAP_HEAD64 = 2 };
template <int MAP> __device__ __forceinline__ int src_col(int p) {
    if (MAP == MAP_SWIGLU) { const int pn = p >> 8, bj = (p >> 7) & 1, wc = (p >> 5) & 3, fq = (p >> 3) & 3, n = (p >> 2) & 1, i = p & 3; return (n ? FF : 0) + 128 * pn + 32 * wc + 8 * fq + 4 * bj + i; }
    if (MAP == MAP_HEAD64) { const int pn = p >> 8, bj = (p >> 7) & 1, wc = (p >> 5) & 3; return 256 * pn + 64 * wc + 32 * bj + (p & 31); }
    return p;
}
template <int MAP> __device__ __forceinline__ void p0_transpose_item(const float* W, int ldw, int K, int Nphys, int col_off, const float* gain, const float* cscale, bf16* WT, int row_off, LAS float* scr, int item, int lane) {
    const int nblk = Nphys / 32, kb = item / nblk, nb = item % nblk, k0 = 64 * kb, n0 = 32 * nb;
    const int sc = src_col<MAP>(n0 + (lane & 31)); const float cs = cscale ? cscale[sc] : 1.0f;
    float wv[32];
#pragma unroll
    for (int i = 0; i < 32; ++i) wv[i] = __builtin_nontemporal_load(W + (size_t)(k0 + 2 * i + (lane >> 5)) * ldw + col_off + sc);
#pragma unroll
    for (int i = 0; i < 32; ++i) { const int kk = 2 * i + (lane >> 5); const float g = gain ? gain[k0 + kk] : 1.0f; scr[kk * 33 + (lane & 31)] = wv[i] * g * cs; }
    LDS_WAIT(); asm volatile("" ::: "memory");
    const int c = lane & 7;
#pragma unroll
    for (int j = 0; j < 4; ++j) { const int n = (lane >> 3) + 8 * j; const LAS float* s = scr + (8 * c) * 33 + n;
        v4u o; o.x = pk2(s[0 * 33], s[1 * 33]); o.y = pk2(s[2 * 33], s[3 * 33]); o.z = pk2(s[4 * 33], s[5 * 33]); o.w = pk2(s[6 * 33], s[7 * 33]);
        *(GAS v4u*)(WT + (size_t)(row_off + n0 + n) * K + k0 + 8 * c) = o; }
    LDS_WAIT(); asm volatile("" ::: "memory");
}
template <int NR> __device__ __forceinline__ void rows_to_bf16(Frame& F, const float* src, size_t rstride, bf16* dst, float* ss) {
    f32x4 v[NR][4];
#pragma unroll
    for (int r = 0; r < NR; ++r)
#pragma unroll
        for (int j = 0; j < 4; ++j) v[r][j] = __builtin_nontemporal_load((const f32x4*)(src + r * rstride) + F.lane + 64 * j);
#pragma unroll
    for (int r = 0; r < NR; ++r) { float s = 0.f;
#pragma unroll
        for (int j = 0; j < 4; ++j) s += (v[r][j].x * v[r][j].x + v[r][j].y * v[r][j].y) + (v[r][j].z * v[r][j].z + v[r][j].w * v[r][j].w);
        s = wave_sum(s);
        GAS unsigned long long* o8 = (GAS unsigned long long*)(dst + r * rstride) + F.lane;
#pragma unroll
        for (int j = 0; j < 4; ++j) o8[64 * j] = (unsigned long long)pk2(v[r][j].x, v[r][j].y) | ((unsigned long long)pk2(v[r][j].z, v[r][j].w) << 32);
        if (F.lane == 0) ss[r] = s; }
}
__device__ __forceinline__ void p0_prologue(Frame& F) {
    LAS float* scr = (LAS float*)(F.lds + F.wave * 16384);
    const int gw = blockIdx.x * NWAVES + F.wave, NGW = F.G * NWAVES;
    const float* g_mix = F.in[10]; const float* w_in = F.in[11]; const float* w_out = F.in[12]; const float* g_ffn = F.in[13]; const float* w_gu = F.in[14]; const float* w_down = F.in[15];
    const float* g_mem = F.in[16]; const float* w_mkv = F.in[17]; const float* w_pool = F.in[20]; const float* pscale = F.in[21]; const float* g_kv = F.in[22]; const float* w_kv = F.in[23]; const float* w_fg = F.in[25];
    bf16* WIN0 = (bf16*)(F.ws + F_WIN0); bf16* W6 = (bf16*)(F.ws + F_W6); bf16* WOUT = (bf16*)(F.ws + F_WOUT); bf16* WGU = (bf16*)(F.ws + F_WGU); bf16* WDOWN = (bf16*)(F.ws + F_WDOWN);
    bf16* WMEM = (bf16*)(F.ws + F_WMEM); bf16* WPOOL = (bf16*)(F.ws + F_WPOOL);
    constexpr int I_SQ = (D / 64) * (D / 32);
    constexpr int I_GU = (D / 64) * (2 * FF / 32), I_DN = (FF / 64) * (D / 32), I_PL = (128 / 64) * (128 / 32);
    constexpr int NITEMS = I_SQ   + 2 * I_SQ   + 2 * I_SQ   + 2 * I_GU + 2 * I_DN + 2 * I_SQ   + 4 * I_PL;
    for (int it = gw; it < NITEMS; it += NGW) {
        int r = it;
        if (r < I_SQ) { p0_transpose_item<MAP_ID>(w_in, D, D, D, 0, g_mix, nullptr, WIN0, 0, scr, r, F.lane); continue; } r -= I_SQ;
        if (r < I_SQ) { p0_transpose_item<MAP_HEAD64>(w_kv, D, D, D, 0, g_kv, nullptr, W6, 0, scr, r, F.lane); continue; } r -= I_SQ;
        if (r < I_SQ) { p0_transpose_item<MAP_HEAD64>(w_in + (size_t)D * D, D, D, D, 0, g_mix + D, nullptr, W6, D, scr, r, F.lane); continue; } r -= I_SQ;
        if (r < 2 * I_SQ) { const int l = r / I_SQ; p0_transpose_item<MAP_ID>(w_out + (size_t)l * D * D, D, D, D, 0, nullptr, nullptr, WOUT + (size_t)l * D * D, 0, scr, r % I_SQ, F.lane); continue; } r -= 2 * I_SQ;
        if (r < 2 * I_GU) { const int l = r / I_GU; p0_transpose_item<MAP_SWIGLU>(w_gu + (size_t)l * D * 2 * FF, 2 * FF, D, 2 * FF, 0, g_ffn + l * D, nullptr, WGU + (size_t)l * 2 * FF * D, 0, scr, r % I_GU, F.lane); continue; } r -= 2 * I_GU;
        if (r < 2 * I_DN) { const int l = r / I_DN; p0_transpose_item<MAP_ID>(w_down + (size_t)l * FF * D, D, FF, D, 0, nullptr, nullptr, WDOWN + (size_t)l * D * FF, 0, scr, r % I_DN, F.lane); continue; } r -= 2 * I_DN;
        if (r < 2 * I_SQ) { const int l = r / I_SQ; p0_transpose_item<MAP_ID>(w_mkv + (size_t)l * D * D, D, D, D, 0, g_mem + l * D, nullptr, WMEM, l * D, scr, r % I_SQ, F.lane); continue; } r -= 2 * I_SQ;
        { const int g = r / I_PL; p0_transpose_item<MAP_ID>(w_pool + (size_t)g * 128 * 128, 128, 128, 128, 0, nullptr, pscale + g * 128, WPOOL + (size_t)g * 128 * 128, 0, scr, r % I_PL, F.lane); }
    }
    { float* WFG = (float*)(F.ws + F_WFG); for (int i = blockIdx.x * 512 + F.tid; i < 8 * D; i += F.G * 512) { const int h = i >> 10, k = i & 1023; WFG[i] = w_fg[k * 8 + h] * g_kv[k]; } }
    bf16* XB = (bf16*)(F.ws + F_XB); float* SS0 = (float*)(F.ws + F_SS0);
    for (int m = 4 * gw; m < M; m += 4 * NGW) { const float* src = (m < MP) ? F.in[0] + (size_t)m * D : F.in[1] + (size_t)(m - MP) * D; rows_to_bf16<4>(F, src, D, XB + (size_t)m * D, SS0 + m); }
    bf16* MEMB = (bf16*)(F.ws + F_MEMB); float* SSM = (float*)(F.ws + F_SSM);
    for (int m = 4 * gw; m < MEMROWS; m += 4 * NGW) rows_to_bf16<4>(F, F.in[9] + (size_t)m * D, D, MEMB + (size_t)m * D, SSM + m);
}

constexpr int KPB = 1040;
template <int HD> __device__ __forceinline__ int v_off(int kv, int c16) { return HD == 64 ? kv * 128 + ((c16 ^ (4 * ((kv >> 1) & 1))) << 4) : kv * 256 + ((c16 ^ (4 * (kv & 3))) << 4); }
typedef short s16x4_t __attribute__((ext_vector_type(4)));
__device__ __forceinline__ s16x4_t tr_read(const LAS unsigned char* p) { return __builtin_amdgcn_ds_read_tr16_b64_v4i16((LAS s16x4_t*)p); }
constexpr float NEG_BIG = -1.0e30f;
template <int HD> struct AttnSt { float m, l; f32x16 o[HD / 32]; };
template <int HD> __device__ __forceinline__ void attn_init(AttnSt<HD>& S) {
    S.m = NEG_BIG; S.l = 0.f;
#pragma unroll
    for (int i = 0; i < HD / 32; ++i)
#pragma unroll
        for (int r = 0; r < 16; ++r) S.o[i][r] = 0.f;
}
template <int HD, bool BIAS, bool MASK, bool NOMAX = false>
__device__ __forceinline__ void attn_tile(AttnSt<HD>& S, const LAS unsigned char* Kt, const LAS unsigned char* Vt, const bf16x8 (&qf)[HD / 16], const LAS float* nb, int kpos0, int qpos, int nvalid, int lane) {
    const int r32 = lane & 31, hi = lane >> 5;
    f32x16 p[2];
    bf16x8 ka[2][HD / 16];
#pragma unroll
    for (int kvb = 0; kvb < 2; ++kvb)
#pragma unroll
        for (int d0 = 0; d0 < HD / 16; ++d0) ka[kvb][d0] = *(const LAS bf16x8*)(Kt + (d0 * 2 + hi) * KPB + (32 * kvb + r32) * 16);
    __builtin_amdgcn_sched_barrier(0);
#pragma unroll
    for (int kvb = 0; kvb < 2; ++kvb) {
#pragma unroll
        for (int r = 0; r < 16; ++r) p[kvb][r] = NOMAX ? -S.m : 0.f;
#pragma unroll
        for (int d0 = 0; d0 < HD / 16; ++d0) p[kvb] = __builtin_amdgcn_mfma_f32_32x32x16_bf16(ka[kvb][d0], qf[d0], p[kvb], 0, 0, 0);
    }
    s16x4_t va[HD / 32][2][2][2];
    {   const int g = lane >> 4, q4 = (lane >> 2) & 3, p4 = lane & 3;
#pragma unroll
        for (int i = 0; i < HD / 32; ++i) { const int dcol = 32 * i + 16 * (g & 1) + 4 * p4, c16 = dcol >> 3, hb = ((dcol >> 2) & 1) * 8;
#pragma unroll
            for (int kvb = 0; kvb < 2; ++kvb)
#pragma unroll
                for (int s = 0; s < 2; ++s) { const int kvA = 32 * kvb + 16 * s + 4 * hi + q4;
                    va[i][kvb][s][0] = tr_read(Vt + v_off<HD>(kvA, c16) + hb); va[i][kvb][s][1] = tr_read(Vt + v_off<HD>(kvA + 8, c16) + hb); } }
    }
    __builtin_amdgcn_sched_barrier(0);
    if (BIAS) {
#pragma unroll
        for (int kvb = 0; kvb < 2; ++kvb)
#pragma unroll
            for (int g = 0; g < 4; ++g) { const f32x4 b = *(const LAS f32x4*)(nb + 32 * kvb + 8 * g + 4 * hi);
                p[kvb][4 * g + 0] += b.x; p[kvb][4 * g + 1] += b.y; p[kvb][4 * g + 2] += b.z; p[kvb][4 * g + 3] += b.w; }
    }
    if (MASK) {
#pragma unroll
        for (int kvb = 0; kvb < 2; ++kvb)
#pragma unroll
            for (int r = 0; r < 16; ++r) { const int kv = 32 * kvb + (r & 3) + 8 * (r >> 2) + 4 * hi; if (kv >= nvalid || kpos0 + kv > qpos) p[kvb][r] = NEG_BIG; }
    }
    if (NOMAX) {
        float rs = 0.f;
#pragma unroll
        for (int kvb = 0; kvb < 2; ++kvb)
#pragma unroll
            for (int r = 0; r < 16; ++r) { p[kvb][r] = __builtin_amdgcn_exp2f(p[kvb][r]); rs += p[kvb][r]; }
        S.l += rs;
    } else {
    float mx = p[0][0];
#pragma unroll
    for (int r = 1; r < 16; ++r) mx = fmaxf(mx, p[0][r]);
#pragma unroll
    for (int r = 0; r < 16; ++r) mx = fmaxf(mx, p[1][r]);
    mx = fmaxf(mx, __shfl_xor(mx, 32));
    const float mn = fmaxf(S.m, mx), alpha = __builtin_amdgcn_exp2f(S.m - mn);
    S.m = mn;
    float rs = 0.f;
#pragma unroll
    for (int kvb = 0; kvb < 2; ++kvb)
#pragma unroll
        for (int r = 0; r < 16; ++r) { p[kvb][r] = __builtin_amdgcn_exp2f(p[kvb][r] - mn); rs += p[kvb][r]; }
    S.l = S.l * alpha + rs;
#pragma unroll
    for (int i = 0; i < HD / 32; ++i)
#pragma unroll
        for (int r = 0; r < 16; ++r) S.o[i][r] *= alpha;
    }
    bf16x8 pf[2][2];
#pragma unroll
    for (int kvb = 0; kvb < 2; ++kvb)
#pragma unroll
        for (int s = 0; s < 2; ++s) { v4u w; w.x = pk2(p[kvb][8 * s + 0], p[kvb][8 * s + 1]); w.y = pk2(p[kvb][8 * s + 2], p[kvb][8 * s + 3]); w.z = pk2(p[kvb][8 * s + 4], p[kvb][8 * s + 5]); w.w = pk2(p[kvb][8 * s + 6], p[kvb][8 * s + 7]);
            pf[kvb][s] = __builtin_bit_cast(bf16x8, w); }
#pragma unroll
    for (int i = 0; i < HD / 32; ++i)
#pragma unroll
        for (int kvb = 0; kvb < 2; ++kvb)
#pragma unroll
            for (int s = 0; s < 2; ++s) { const s16x4_t lo = va[i][kvb][s][0], hi4 = va[i][kvb][s][1];
                const bf16x8 a = {lo[0], lo[1], lo[2], lo[3], hi4[0], hi4[1], hi4[2], hi4[3]};
                S.o[i] = __builtin_amdgcn_mfma_f32_32x32x16_bf16(a, pf[kvb][s], S.o[i], 0, 0, 0); }
}

struct AttnSt16 { float m, l; f32x4 o[4]; };
__device__ __forceinline__ void attn_init16(AttnSt16& S, float mref) { S.m = mref; S.l = 0.f;
#pragma unroll
    for (int i = 0; i < 4; ++i) S.o[i] = (f32x4){0.f, 0.f, 0.f, 0.f}; }
template <bool MASK>
__device__ __forceinline__ void attn_tile16(AttnSt16& S, const LAS unsigned char* Kt, const LAS unsigned char* Vt, const LAS unsigned char* qp, const LAS float* nb, int kpos0, int qpos, int nvalid, int lane) {
    const int q = lane & 15, kq = lane >> 4;
    bf16x8 qf[2];
#pragma unroll
    for (int ks = 0; ks < 2; ++ks) { qf[ks] = *(const LAS bf16x8*)(qp + ((4 * ks + kq) * 8 + (q & 7)) * 16); if (q >= 8) qf[ks] = (bf16x8){0, 0, 0, 0, 0, 0, 0, 0}; }
    f32x4 p[4]; float rs = 0.f;
#pragma unroll
    for (int blk = 0; blk < 4; ++blk) {
        p[blk] = (f32x4){-S.m, -S.m, -S.m, -S.m};
#pragma unroll
        for (int ks = 0; ks < 2; ++ks) { const bf16x8 a = *(const LAS bf16x8*)(Kt + (4 * ks + kq) * KPB + (16 * blk + q) * 16); p[blk] = __builtin_amdgcn_mfma_f32_16x16x32_bf16(a, qf[ks], p[blk], 0, 0, 0); }
        const f32x4 bb = *(const LAS f32x4*)(nb + 16 * blk + 4 * kq);
        p[blk] += bb;
        if (MASK) {
#pragma unroll
            for (int r = 0; r < 4; ++r) { const int kv = 16 * blk + 4 * kq + r; if (kv >= nvalid || kpos0 + kv > qpos) p[blk][r] = NEG_BIG; } }
#pragma unroll
        for (int r = 0; r < 4; ++r) { p[blk][r] = __builtin_amdgcn_exp2f(p[blk][r]); rs += p[blk][r]; }
    }
    S.l += rs;
    const int q4 = (lane >> 2) & 3, p4 = lane & 3;
#pragma unroll
    for (int s = 0; s < 2; ++s) {
        v4u w; w.x = pk2(p[2 * s][0], p[2 * s][1]); w.y = pk2(p[2 * s][2], p[2 * s][3]); w.z = pk2(p[2 * s + 1][0], p[2 * s + 1][1]); w.w = pk2(p[2 * s + 1][2], p[2 * s + 1][3]);
        const bf16x8 pf = __builtin_bit_cast(bf16x8, w);
        const int kvA = 32 * s + 4 * kq + q4;
#pragma unroll
        for (int dblk = 0; dblk < 4; ++dblk) { const int c16 = 2 * dblk + (p4 >> 1), hb = (p4 & 1) * 8;
            const s16x4_t lo = tr_read(Vt + v_off<64>(kvA, c16) + hb), hi4 = tr_read(Vt + v_off<64>(kvA + 16, c16) + hb);
            const bf16x8 a = {lo[0], lo[1], lo[2], lo[3], hi4[0], hi4[1], hi4[2], hi4[3]};
            S.o[dblk] = __builtin_amdgcn_mfma_f32_16x16x32_bf16(a, pf, S.o[dblk], 0, 0, 0); }
    }
}
template <int HD> __device__ __forceinline__ void load_q(bf16x8 (&qf)[HD / 16], const bf16* zrow  , const float* g, float qscale, bool valid, int lane) {
    const int hi = lane >> 5;
    v4u raw[HD / 16]; float s = 0.f;
#pragma unroll
    for (int d0 = 0; d0 < HD / 16; ++d0) { raw[d0] = valid ? *(const v4u*)(zrow + 16 * d0 + 8 * hi) : (v4u){0u, 0u, 0u, 0u};
        const float a0 = bf_lo(raw[d0].x), a1 = bf_hi(raw[d0].x), a2 = bf_lo(raw[d0].y), a3 = bf_hi(raw[d0].y), a4 = bf_lo(raw[d0].z), a5 = bf_hi(raw[d0].z), a6 = bf_lo(raw[d0].w), a7 = bf_hi(raw[d0].w);
        s += (a0 * a0 + a1 * a1) + (a2 * a2 + a3 * a3) + (a4 * a4 + a5 * a5) + (a6 * a6 + a7 * a7); }
    s += __shfl_xor(s, 32);
    const float r = qscale / sqrtf(s * (1.0f / HD) + EPS);
#pragma unroll
    for (int d0 = 0; d0 < HD / 16; ++d0) { const f32x4 g0 = *(const f32x4*)(g + 16 * d0 + 8 * hi), g1 = *(const f32x4*)(g + 16 * d0 + 8 * hi + 4);
        v4u w; w.x = pk2(bf_lo(raw[d0].x) * r * g0.x, bf_hi(raw[d0].x) * r * g0.y); w.y = pk2(bf_lo(raw[d0].y) * r * g0.z, bf_hi(raw[d0].y) * r * g0.w);
        w.z = pk2(bf_lo(raw[d0].z) * r * g1.x, bf_hi(raw[d0].z) * r * g1.y); w.w = pk2(bf_lo(raw[d0].w) * r * g1.z, bf_hi(raw[d0].w) * r * g1.w);
        qf[d0] = __builtin_bit_cast(bf16x8, w); }
}
template <int HD, bool WT = false> __device__ __forceinline__ void store_o(const AttnSt<HD>& S, bf16* orow, int lane) {
    const int hi = lane >> 5; const float lt = S.l + __shfl_xor(S.l, 32); const float inv = 1.0f / lt;
#pragma unroll
    for (int i = 0; i < HD / 32; ++i)
#pragma unroll
        for (int j = 0; j < 2; ++j) {
            const unsigned x0 = pk2(S.o[i][8 * j + 0] * inv, S.o[i][8 * j + 1] * inv), x1 = pk2(S.o[i][8 * j + 2] * inv, S.o[i][8 * j + 3] * inv);
            const unsigned y0 = pk2(S.o[i][8 * j + 4] * inv, S.o[i][8 * j + 5] * inv), y1 = pk2(S.o[i][8 * j + 6] * inv, S.o[i][8 * j + 7] * inv);
            const auto r0 = __builtin_amdgcn_permlane32_swap(x0, y0, false, false), r1 = __builtin_amdgcn_permlane32_swap(x1, y1, false, false);
            v4u w; w.x = r0[0]; w.y = r1[0]; w.z = r0[1]; w.w = r1[1];
            *(v4u*)(orow + 32 * i + 16 * j + 8 * hi) = w; }
}
__device__ __forceinline__ void arrive(Frame& F, int cw) {
    asm volatile("s_waitcnt vmcnt(0)" ::: "memory");
    __syncthreads();
    if (F.tid == 0) (void)__hip_atomic_fetch_add((unsigned*)(F.ctl + cw), 1u, __ATOMIC_RELAXED, __HIP_MEMORY_SCOPE_AGENT);
}
__device__ __forceinline__ void wait_count(Frame& F, int cw, unsigned want) {
    if (F.tid == 0) {
        unsigned sp = 0;
        while (__hip_atomic_load((unsigned*)(F.ctl + cw), __ATOMIC_RELAXED, __HIP_MEMORY_SCOPE_AGENT) < want) {
            __builtin_amdgcn_s_sleep(2);
            if (++sp > (1u << 22)) { __hip_atomic_store((unsigned*)(F.ctl + CW_TMO), 1u, __ATOMIC_RELAXED, __HIP_MEMORY_SCOPE_AGENT); break; }
        }
        __builtin_amdgcn_fence(__ATOMIC_ACQUIRE, "agent");
        asm volatile("s_waitcnt vmcnt(0)" ::: "memory");
    }
    __syncthreads();
}
namespace sg {
constexpr int PITCH = 144, TILEB = 64 * PITCH, RED_OFF = 6 * TILEB;
struct MapId { __device__ __forceinline__ int operator()(int L) const { return L; } };
struct MapHead64 { __device__ __forceinline__ int operator()(int L) const { return (L & ~255) | (((L >> 5) & 1) << 7) | (((L >> 6) & 3) << 5) | (L & 31); } };
template <int RB, class BMap, class Epi>
__device__ __forceinline__ void small_gemm(Frame& F, const bf16* A, const bf16* Bt, int K, int tm, int tn, int row_base, const BMap& bm, const Epi& E) {
    int tid_ = F.tid; asm volatile("" : "+v"(tid_));
    const int lr = tid_ >> 3, lc = tid_ & 7, wm = F.wave & 3, kh = F.wave >> 2, r = tid_ & 15, kq = (tid_ & 63) >> 4;
    const bf16* ap = A + (size_t)(tm * 64 * RB + lr) * K + lc * 8; const bf16* bp = Bt + (size_t)bm(tn * 64 + lr) * K + lc * 8;
    constexpr int ATILE = RB * TILEB;
    LAS unsigned char* sA = F.lds; LAS unsigned char* sB = F.lds + 2 * ATILE;
    const int woff = lr * PITCH + lc * 16, aoff = (16 * wm + r) * PITCH + (32 * kh + 8 * kq) * 2, boff = r * PITCH + (32 * kh + 8 * kq) * 2;
    f32x4 acc[RB][4];
#pragma unroll
    for (int rb = 0; rb < RB; ++rb)
#pragma unroll
        for (int cb = 0; cb < 4; ++cb) acc[rb][cb] = (f32x4){0.f, 0.f, 0.f, 0.f};
    const int nk = K / 64;
    constexpr int PF = 8;
    v4u ra[PF][RB], rb_[PF];
#pragma unroll
    for (int j = 0; j < PF; ++j) if (j < nk) {
#pragma unroll
        for (int rb = 0; rb < RB; ++rb) ra[j][rb] = *(const v4u*)(ap + (size_t)rb * 64 * K + j * 64);
        rb_[j] = *(const v4u*)(bp + j * 64); }
#pragma unroll
    for (int rb = 0; rb < RB; ++rb) *(LAS v4u*)(sA + rb * TILEB + woff) = ra[0][rb];
    *(LAS v4u*)(sB + woff) = rb_[0];
    __syncthreads();
#pragma unroll 1
    for (int s0 = 0; s0 < nk; s0 += PF) {
#pragma unroll
        for (int j = 0; j < PF; ++j) { const int s = s0 + j;
            if (s < nk) {
                const int bo = (s & 1) * TILEB, ao = (s & 1) * ATILE;
                bf16x8 af[RB];
#pragma unroll
                for (int rb = 0; rb < RB; ++rb) af[rb] = *(const LAS bf16x8*)(sA + ao + rb * TILEB + aoff);
#pragma unroll
                for (int cb = 0; cb < 4; ++cb) { const bf16x8 bfr = *(const LAS bf16x8*)(sB + bo + boff + cb * 16 * PITCH);
#pragma unroll
                    for (int rb = 0; rb < RB; ++rb) acc[rb][cb] = __builtin_amdgcn_mfma_f32_16x16x32_bf16(bfr, af[rb], acc[rb][cb], 0, 0, 0); }
                if (s + 1 < nk) { const int no = ((s + 1) & 1) * TILEB, na = ((s + 1) & 1) * ATILE;
#pragma unroll
                    for (int rb = 0; rb < RB; ++rb) *(LAS v4u*)(sA + na + rb * TILEB + woff) = ra[(j + 1) % PF][rb];
                    *(LAS v4u*)(sB + no + woff) = rb_[(j + 1) % PF]; }
                if (s + PF < nk) {
#pragma unroll
                    for (int rb = 0; rb < RB; ++rb) ra[j][rb] = *(const v4u*)(ap + (size_t)rb * 64 * K + (size_t)(s + PF) * 64);
                    rb_[j] = *(const v4u*)(bp + (size_t)(s + PF) * 64); }
                __syncthreads();
            }
        }
    }
    LAS f32x4* red = (LAS f32x4*)(F.lds + RED_OFF);
    if (kh == 1) {
#pragma unroll
        for (int rb = 0; rb < RB; ++rb)
#pragma unroll
            for (int cb = 0; cb < 4; ++cb) red[((rb * 4 + wm) * 4 + cb) * 64 + (tid_ & 63)] = acc[rb][cb];
    }
    __syncthreads();
    if (kh == 0) {
#pragma unroll
        for (int rb = 0; rb < RB; ++rb) {
#pragma unroll
            for (int cb = 0; cb < 4; ++cb) acc[rb][cb] += red[((rb * 4 + wm) * 4 + cb) * 64 + (tid_ & 63)];
            E(row_base + tm * 64 * RB + 64 * rb + 16 * wm + r, tn, acc[rb], kq); }
    }
}
template <class BMap, class Epi>
__device__ __forceinline__ void small_gemm(Frame& F, const bf16* A, const bf16* Bt, int K, int tm, int tn, int row_base, const BMap& bm, const Epi& E) { small_gemm<1>(F, A, Bt, K, tm, tn, row_base, bm, E); }
struct EScale {
    bf16* O; int ldc; const float* ss; int nparts;
    __device__ __forceinline__ void operator()(int row, int ct, const f32x4 (&acc)[4], int kq) const {
        const float rs = row_rstd(ss, nparts, row); bf16* o = O + (size_t)row * ldc + 64 * ct + 4 * kq;
#pragma unroll
        for (int cb = 0; cb < 4; ++cb) { const f32x4 v = acc[cb] * rs; v2u w; w.x = pk2(v[0], v[1]); w.y = pk2(v[2], v[3]); *(v2u*)(o + 16 * cb) = w; }
    }
};
struct EMemKV {
    bf16* MKB; bf16* MVB; float* mv_out; const float* ss; int l;
    __device__ __forceinline__ void operator()(int row, int ct, const f32x4 (&acc)[4], int kq) const {
        const float rs = row_rstd(ss, 1, row); const bool isv = ct >= 8; const size_t off = ((size_t)l * MEMROWS + row) * TOKW + 64 * (ct & 7) + 4 * kq;
#pragma unroll
        for (int cb = 0; cb < 4; ++cb) { const f32x4 v = acc[cb] * rs; v2u w; w.x = pk2(v[0], v[1]); w.y = pk2(v[2], v[3]);
            if (isv) { *(v2u*)(MVB + off + 16 * cb) = w; *(f32x4*)(mv_out + off + 16 * cb) = v; } else *(v2u*)(MKB + off + 16 * cb) = w; }
    }
};
struct EResid {
    const bf16* hin; bf16* HB; float* y32; float* ssout;
    __device__ __forceinline__ void operator()(int row, int ct, const f32x4 (&acc)[4], int kq) const {
        const size_t off = (size_t)row * D + 64 * ct + 4 * kq; float s = 0.f;
#pragma unroll
        for (int cb = 0; cb < 4; ++cb) { const v2u r = *(const v2u*)(hin + off + 16 * cb); const f32x4 v = acc[cb] + (f32x4){bf_lo(r.x), bf_hi(r.x), bf_lo(r.y), bf_hi(r.y)};
            if (y32) *(f32x4*)(y32 + off + 16 * cb) = v;
            if (HB) { v2u w; w.x = pk2(v[0], v[1]); w.y = pk2(v[2], v[3]); *(v2u*)(HB + off + 16 * cb) = w; }
            s += (v[0] * v[0] + v[1] * v[1]) + (v[2] * v[2] + v[3] * v[3]); }
        if (ssout) { s += __shfl_xor(s, 16); s += __shfl_xor(s, 32); if (kq == 0) ssout[(size_t)row * 16 + ct] = s; }
    }
};
struct EKVQ {
    bf16* KB; bf16* VB; bf16* Z1B; float* k_s; float* v_s; const float* g_fox_k; const float* ss;
    __device__ __forceinline__ void operator()(int row, int ct, const f32x4 (&acc)[4], int kq) const {
        const float rs = row_rstd(ss, 16, row); f32x4 v[4]; float s = 0.f;
#pragma unroll
        for (int cb = 0; cb < 4; ++cb) { v[cb] = acc[cb] * rs; s += (v[cb][0] * v[cb][0] + v[cb][1] * v[cb][1]) + (v[cb][2] * v[cb][2] + v[cb][3] * v[cb][3]); }
        if (ct < 8) { s += __shfl_xor(s, 16); s += __shfl_xor(s, 32); const float rk = 1.0f / sqrtf(s * (1.0f / 64.0f) + EPS);
#pragma unroll
            for (int cb = 0; cb < 4; ++cb) v[cb] = v[cb] * rk * *(const f32x4*)(g_fox_k + 16 * cb + 4 * kq); }
        if (ct < 16) { float* o32 = (ct < 8 ? k_s : v_s) + (size_t)(row - MP) * TOKW + 64 * (ct & 7) + 4 * kq; bf16* o16 = (ct < 8 ? KB : VB) + (size_t)row * TOKW + 64 * (ct & 7) + 4 * kq;
#pragma unroll
            for (int cb = 0; cb < 4; ++cb) { *(f32x4*)(o32 + 16 * cb) = v[cb]; v2u w; w.x = pk2(v[cb][0], v[cb][1]); w.y = pk2(v[cb][2], v[cb][3]); *(v2u*)(o16 + 16 * cb) = w; } }
        else { bf16* o16 = Z1B + (size_t)row * D + 64 * (ct - 16) + 4 * kq;
#pragma unroll
            for (int cb = 0; cb < 4; ++cb) { v2u w; w.x = pk2(v[cb][0], v[cb][1]); w.y = pk2(v[cb][2], v[cb][3]); *(v2u*)(o16 + 16 * cb) = w; } }
    }
};
}
constexpr float C2MEM = 0.08838834764831845f * LOG2E, C2FOX = 0.125f * LOG2E;
constexpr int KT128 = 16 * KPB  , VT128 = 64 * 256  , KT64 = 8 * KPB  , VT64 = 64 * 128  ;
constexpr int MEM_K_OFF = 0, MEM_V_OFF = 4 * KT128  , MEM_END = MEM_V_OFF + 4 * VT128  ;
static_assert(MEM_END + 4 * 8 * 128 * 4 + 256 <= LCTL_OFF, "memory-attention LDS map");

template <int HD> __device__ __forceinline__ void merge_write(const AttnSt<HD>& S, LAS float* mbuf, int nw, int w, int lane) {
    const int r32 = lane & 31, hi = lane >> 5; const float lt = S.l + __shfl_xor(S.l, 32);
    if (r32 < 8) {
        LAS float* O = mbuf + ((size_t)w * 8 + r32) * HD;
#pragma unroll
        for (int i = 0; i < HD / 32; ++i)
#pragma unroll
            for (int r = 0; r < 16; ++r) O[32 * i + (r & 3) + 8 * (r >> 2) + 4 * hi] = S.o[i][r];
        if (hi == 0) { LAS float* ML = mbuf + (size_t)nw * 8 * HD + (w * 8 + r32) * 2; ML[0] = S.m; ML[1] = lt; }
    }
}
__device__ __forceinline__ void merge_write16(const AttnSt16& S, LAS float* mbuf, int nw, int w, int lane) {
    const int q = lane & 15, kq = lane >> 4; float lt = S.l; lt += __shfl_xor(lt, 16); lt += __shfl_xor(lt, 32);
    if (q < 8) {
        LAS float* O = mbuf + ((size_t)w * 8 + q) * 64;
#pragma unroll
        for (int i = 0; i < 4; ++i) *(LAS f32x4*)(O + 16 * i + 4 * kq) = S.o[i];
        if (kq == 0) { LAS float* ML = mbuf + (size_t)nw * 8 * 64 + (w * 8 + q) * 2; ML[0] = S.m; ML[1] = lt; }
    }
}
template <int HD> __device__ __forceinline__ float merge_read(const LAS float* mbuf, int nw, int q, int d) {
    const LAS float* ML = mbuf + (size_t)nw * 8 * HD; float mx = NEG_BIG;
    for (int w = 0; w < nw; ++w) mx = fmaxf(mx, ML[(w * 8 + q) * 2]);
    float num = 0.f, den = 0.f;
    for (int w = 0; w < nw; ++w) { const float f = __builtin_amdgcn_exp2f(ML[(w * 8 + q) * 2] - mx); num += f * mbuf[((size_t)w * 8 + q) * HD + d]; den += f * ML[(w * 8 + q) * 2 + 1]; }
    return num / den;
}

__device__ __forceinline__ void unit_pm(Frame& F, QState& qs, int qid, int l, int b, int hd, int qb) {
    int tid_ = F.tid, lane_ = F.lane; asm volatile("" : "+v"(tid_), "+v"(lane_));
    const bf16* MKB = (const bf16*)(F.ws + F_MKB); const bf16* MVB = (const bf16*)(F.ws + F_MVB);
    const bf16* Z = (const bf16*)(F.ws + (l == 0 ? F_ZB : F_Z1B)); bf16* MIXB = (bf16*)(F.ws + F_MIXB) + (size_t)l * M * D;
    const float* g_mem_k = F.in[19] + l * 128; const float* g_mem_q = F.in[18] + l * 128;
    {
        const int c = tid_ & 15, r0 = tid_ >> 4; const size_t cbase = ((size_t)l * MEMROWS + b * NMEM) * TOKW + hd * 128 + 8 * c;
        v4u kr[8], vr[8];
#pragma unroll
        for (int p = 0; p < 8; ++p) { kr[p] = *(const v4u*)(MKB + cbase + (size_t)(r0 + 32 * p) * TOKW); vr[p] = *(const v4u*)(MVB + cbase + (size_t)(r0 + 32 * p) * TOKW); }
        const f32x4 g0 = *(const f32x4*)(g_mem_k + 8 * c), g1 = *(const f32x4*)(g_mem_k + 8 * c + 4);
#pragma unroll
        for (int p = 0; p < 8; ++p) { const int kv = r0 + 32 * p;
            const float a0 = bf_lo(kr[p].x), a1 = bf_hi(kr[p].x), a2 = bf_lo(kr[p].y), a3 = bf_hi(kr[p].y), a4 = bf_lo(kr[p].z), a5 = bf_hi(kr[p].z), a6 = bf_lo(kr[p].w), a7 = bf_hi(kr[p].w);
            float s = (a0 * a0 + a1 * a1) + (a2 * a2 + a3 * a3) + (a4 * a4 + a5 * a5) + (a6 * a6 + a7 * a7);
            s += __shfl_xor(s, 1); s += __shfl_xor(s, 2); s += __shfl_xor(s, 4); s += __shfl_xor(s, 8);
            const float r = 1.0f / sqrtf(s * (1.0f / 128.0f) + EPS);
            const f32x4 v0 = {a0 * r * g0.x, a1 * r * g0.y, a2 * r * g0.z, a3 * r * g0.w}, v1 = {a4 * r * g1.x, a5 * r * g1.y, a6 * r * g1.z, a7 * r * g1.w};
            v4u w; w.x = pk2(v0[0], v0[1]); w.y = pk2(v0[2], v0[3]); w.z = pk2(v1[0], v1[1]); w.w = pk2(v1[2], v1[3]);
            *(LAS v4u*)(F.lds + MEM_K_OFF + (kv >> 6) * KT128 + c * KPB + (kv & 63) * 16) = w;
            if (qb == 0) { float* o = F.O.mk_p + cbase + (size_t)kv * TOKW; *(f32x4*)o = v0; *(f32x4*)(o + 4) = v1; }
            *(LAS v4u*)(F.lds + MEM_V_OFF + (kv >> 6) * VT128 + v_off<128>(kv & 63, c)) = vr[p]; }
    }
    __syncthreads();
    const int r32 = lane_ & 31; const size_t row = (size_t)b * PS + qb * 256 + F.wave * 32 + r32;
    bf16x8 qf[8]; load_q<128>(qf, Z + row * D + TOKW + hd * 128, g_mem_q, C2MEM, true, lane_);
    AttnSt<128> S; attn_init<128>(S); S.m = 0.f;
    q_prefetch(F, qid, qs);
#pragma unroll 1
    for (int t = 0; t < 4; ++t) attn_tile<128, false, false, true>(S, F.lds + MEM_K_OFF + t * KT128, F.lds + MEM_V_OFF + t * VT128, qf, nullptr, 0, 0, 64, lane_);
    store_o<128>(S, MIXB + row * D + TOKW + hd * 128, lane_);
}

__device__ __forceinline__ void unit_sm(Frame& F, QState& qs, int qid, int l, int b, int hd) {
    int tid_ = F.tid, lane_ = F.lane; asm volatile("" : "+v"(tid_), "+v"(lane_));
    const float* CK = F.in[2] + ((size_t)(l * SB + b) * NMEM) * TOKW + hd * 128; const float* CV = F.in[3] + ((size_t)(l * SB + b) * NMEM) * TOKW + hd * 128;
    const bf16* Z = (const bf16*)(F.ws + (l == 0 ? F_ZB : F_Z1B)); bf16* MIXB = (bf16*)(F.ws + F_MIXB) + (size_t)l * M * D; const float* g_mem_q = F.in[18] + l * 128;
    {
        const int rsub = lane_ >> 5, c4 = lane_ & 31;
        f32x4 kx[16], vx[16];
#pragma unroll
        for (int j = 0; j < 16; ++j) { const int kv = F.wave * 32 + 2 * j + rsub; kx[j] = __builtin_nontemporal_load((const f32x4*)(CK + (size_t)kv * TOKW + 4 * c4)); vx[j] = __builtin_nontemporal_load((const f32x4*)(CV + (size_t)kv * TOKW + 4 * c4)); }
#pragma unroll
        for (int j = 0; j < 16; ++j) { const int kv = F.wave * 32 + 2 * j + rsub, t = kv >> 6, kl = kv & 63;
            v2u w; w.x = pk2(kx[j].x, kx[j].y); w.y = pk2(kx[j].z, kx[j].w);
            *(LAS v2u*)(F.lds + MEM_K_OFF + t * KT128 + (c4 >> 1) * KPB + kl * 16 + (c4 & 1) * 8) = w;
            v2u wv_; wv_.x = pk2(vx[j].x, vx[j].y); wv_.y = pk2(vx[j].z, vx[j].w);
            *(LAS v2u*)(F.lds + MEM_V_OFF + t * VT128 + v_off<128>(kl, c4 >> 1) + (c4 & 1) * 8) = wv_; }
    }
    __syncthreads();
    q_prefetch(F, qid, qs);
    LAS float* mbuf = (LAS float*)(F.lds + MEM_END);
    if (F.wave < 4) {
        const int r32 = lane_ & 31; const size_t row = (size_t)MP + b * SS + (r32 & 7);
        bf16x8 qf[8]; load_q<128>(qf, Z + row * D + TOKW + hd * 128, g_mem_q, C2MEM, r32 < 8, lane_);
        AttnSt<128> S; attn_init<128>(S); S.m = 0.f;
        attn_tile<128, false, false, true>(S, F.lds + MEM_K_OFF + F.wave * KT128, F.lds + MEM_V_OFF + F.wave * VT128, qf, nullptr, 0, 0, 64, lane_);
        merge_write<128>(S, mbuf, 4, F.wave, lane_);
    }
    __syncthreads();
    { const int q = tid_ >> 6, d = 2 * (tid_ & 63); const float o0 = merge_read<128>(mbuf, 4, q, d), o1 = merge_read<128>(mbuf, 4, q, d + 1);
      *(unsigned*)(MIXB + ((size_t)MP + b * SS + q) * D + TOKW + hd * 128 + d) = pk2(o0, o1); }
}

__device__ __forceinline__ float block_excl4(Frame& F, float tsum, LAS float* wtot) {
    float inc = tsum;
#pragma unroll
    for (int o = 1; o < 64; o <<= 1) { const float y = __shfl_up(inc, o); if (F.lane >= o) inc += y; }
    if (F.lane == 63) wtot[F.wave] = inc;
    __syncthreads();
    float off = 0.f;
    for (int w = 0; w < F.wave; ++w) off += wtot[w];
    return off + inc - tsum;
}

constexpr int PF_BUF = 18432, PF_NB_OFF = EPX_OFF, PF_WT_OFF = EPX_OFF + 8192;
__device__ __forceinline__ void unit_pf(Frame& F, QState& qs, int qid, int b, int h, int qb) {
    int tid_ = F.tid, lane_ = F.lane; asm volatile("" : "+v"(tid_), "+v"(lane_));
    const bf16* KB = (const bf16*)(F.ws + F_KB); const bf16* VB = (const bf16*)(F.ws + F_VB); const bf16* Z1 = (const bf16*)(F.ws + F_Z1B); bf16* MIXB = (bf16*)(F.ws + F_MIXB) + (size_t)M * D;
    LAS float* nb = (LAS float*)(F.lds + PF_NB_OFF);
    const int NT = 4 * (qb + 1), kv = tid_ >> 3, c = tid_ & 7;
    const size_t gbase = ((size_t)b * PS + kv) * TOKW + h * 64 + 8 * c;
    v4u kr0 = *(const v4u*)(KB + gbase), vr0 = *(const v4u*)(VB + gbase);
    v4u kr1 = *(const v4u*)(KB + gbase + (size_t)64 * TOKW), vr1 = *(const v4u*)(VB + gbase + (size_t)64 * TOKW);
    {
        const float* lf = F.O.lf_p + ((size_t)b * PS + 4 * tid_) * 8 + h;
        const float a0 = lf[0], a1 = lf[8], a2 = lf[16], a3 = lf[24];
        const float ex = block_excl4(F, (a0 + a1) + (a2 + a3), (LAS float*)(F.lds + PF_WT_OFF));
        const float c0 = ex + a0, c1 = c0 + a1, c2 = c1 + a2, c3 = c2 + a3;
        *(LAS f32x4*)(nb + 4 * tid_) = (f32x4){-c0 * LOG2E, -c1 * LOG2E, -c2 * LOG2E, -c3 * LOG2E};
    }
    *(LAS v4u*)(F.lds + c * KPB + kv * 16) = kr0; *(LAS v4u*)(F.lds + KT64 + v_off<64>(kv, c)) = vr0;
    const int r32 = lane_ & 31, qw0 = qb * 256 + F.wave * 32, qpos = qw0 + r32; const size_t row = (size_t)b * PS + qpos;
    bf16x8 qf[4]; load_q<64>(qf, Z1 + row * D + h * 64, F.in[27], C2FOX, true, lane_);
    AttnSt<64> S; attn_init<64>(S);
    __syncthreads();
    S.m = nb[qpos];
#define PF_TILE(t_) do { const LAS unsigned char* Kt = F.lds + ((t_) & 1) * PF_BUF; if (64 * (t_) <= qw0 + 31) { \
            if (64 * (t_) + 63 > qw0) attn_tile<64, true, true, true>(S, Kt, Kt + KT64, qf, nb + 64 * (t_), 64 * (t_), qpos, 64, lane_); \
            else attn_tile<64, true, false, true>(S, Kt, Kt + KT64, qf, nb + 64 * (t_), 64 * (t_), qpos, 64, lane_); } } while (0)
#pragma unroll 1
    for (int t = 0; t < NT; t += 2) {
        if (t == NT - 4) q_prefetch(F, qid, qs);
        if (t + 2 < NT) { kr0 = *(const v4u*)(KB + gbase + (size_t)(t + 2) * 64 * TOKW); vr0 = *(const v4u*)(VB + gbase + (size_t)(t + 2) * 64 * TOKW); }
        PF_TILE(t);
        { LAS unsigned char* Kn = F.lds + PF_BUF; *(LAS v4u*)(Kn + c * KPB + kv * 16) = kr1; *(LAS v4u*)(Kn + KT64 + v_off<64>(kv, c)) = vr1; }
        __syncthreads();
        if (t + 3 < NT) { kr1 = *(const v4u*)(KB + gbase + (size_t)(t + 3) * 64 * TOKW); vr1 = *(const v4u*)(VB + gbase + (size_t)(t + 3) * 64 * TOKW); }
        PF_TILE(t + 1);
        if (t + 2 < NT) { *(LAS v4u*)(F.lds + c * KPB + kv * 16) = kr0; *(LAS v4u*)(F.lds + KT64 + v_off<64>(kv, c)) = vr0; }
        __syncthreads();
    }
#undef PF_TILE
    store_o<64>(S, MIXB + row * D + h * 64, lane_);
}

constexpr int SF_WTILE = KT64 + VT64  , SF_NB_OFF = 8 * SF_WTILE  , SF_WT_OFF = SF_NB_OFF + 2112 * 4, SF_Q_OFF = SF_WT_OFF + 64;
static_assert(SF_Q_OFF + 8 * 1024 <= LCTL_OFF, "SF LDS map");
__device__ __forceinline__ void unit_sf(Frame& F, QState& qs, int qid, int b, int h) {
    int tid_ = F.tid, lane_ = F.lane; asm volatile("" : "+v"(tid_), "+v"(lane_));
    const float* CKc = F.in[5]; const float* CVc = F.in[6]; const float* CLF = F.in[7]; const int* PT = (const int*)F.in[8] + b * NPAGES;
    const bf16* KB = (const bf16*)(F.ws + F_KB); const bf16* VB = (const bf16*)(F.ws + F_VB); const bf16* Z1 = (const bf16*)(F.ws + F_Z1B); bf16* MIXB = (bf16*)(F.ws + F_MIXB) + (size_t)M * D;
    LAS float* nb = (LAS float*)(F.lds + SF_NB_OFF);
    LAS unsigned char* Kt = F.lds + F.wave * SF_WTILE; LAS unsigned char* Vt = Kt + KT64;
    const int rsub = lane_ >> 4, c4 = lane_ & 15;
    f32x4 kx[2][8], vx[2][8];
#define SF_BASE(pg, tile, hf) ((((size_t)(pg) * PAGE + ((tile) & 1) * 64 + (hf) * 32) * 8 + h) * 64 + 4 * c4 + (size_t)rsub * 512)
#define SF_ISSUE(set, pg, tile, hf) do { const size_t o_ = SF_BASE(pg, tile, hf); _Pragma("unroll") for (int j = 0; j < 8; ++j) { kx[set][j] = __builtin_nontemporal_load((const f32x4*)(CKc + o_ + (size_t)j * 4 * 512)); vx[set][j] = __builtin_nontemporal_load((const f32x4*)(CVc + o_ + (size_t)j * 4 * 512)); } } while (0)
#define SF_WRITE(set, hf) do { _Pragma("unroll") for (int j = 0; j < 8; ++j) { const int kv = (hf) * 32 + 4 * j + rsub; v2u w; w.x = pk2(kx[set][j].x, kx[set][j].y); w.y = pk2(kx[set][j].z, kx[set][j].w); \
            *(LAS v2u*)(Kt + (c4 >> 1) * KPB + kv * 16 + (c4 & 1) * 8) = w; \
            v2u wv_; wv_.x = pk2(vx[set][j].x, vx[set][j].y); wv_.y = pk2(vx[set][j].z, vx[set][j].w); *(LAS v2u*)(Vt + v_off<64>(kv, c4 >> 1) + (c4 & 1) * 8) = wv_; } } while (0)
    int pgc = PT[F.wave >> 1];
    SF_ISSUE(0, pgc, F.wave, 0); SF_ISSUE(1, pgc, F.wave, 1);
    const int r32 = lane_ & 31; const size_t qrow = (size_t)MP + b * SS + (r32 & 7);
    LAS unsigned char* qlds = F.lds + SF_Q_OFF + F.wave * 1024 + ((lane_ >> 5) * 8 + (r32 & 7)) * 16;
    {
        const int s0 = 4 * tid_, pg = PT[s0 >> 7]; const float* lf = CLF + ((size_t)pg * PAGE + (s0 & 127)) * 8 + h;
        const float a0 = lf[0], a1 = lf[8], a2 = lf[16], a3 = lf[24];
        const float lnew = (tid_ >= 504) ? F.O.lf_s[((size_t)b * SS + (tid_ - 504)) * 8 + h] : 0.f;
        bf16x8 q0[4]; load_q<64>(q0, Z1 + qrow * D + h * 64, F.in[27], C2FOX, r32 < 8, lane_);
        if (r32 < 8) {
#pragma unroll
            for (int d0 = 0; d0 < 4; ++d0) *(LAS bf16x8*)(qlds + d0 * 256) = q0[d0]; }
        const float ex = block_excl4(F, (a0 + a1) + (a2 + a3), (LAS float*)(F.lds + SF_WT_OFF));
        const float c0 = ex + a0, c1 = c0 + a1, c2 = c1 + a2, c3 = c2 + a3;
        *(LAS f32x4*)(nb + s0) = (f32x4){-c0 * LOG2E, -c1 * LOG2E, -c2 * LOG2E, -c3 * LOG2E};
        if (F.wave == 7) {
            const float tot = __shfl(c3, 63); float inc = lnew;
#pragma unroll
            for (int o = 1; o < 8; o <<= 1) { const float y = __shfl_up(inc, o); if (lane_ >= 56 + o) inc += y; }
            if (lane_ >= 56) nb[PAST + lane_ - 56] = -(tot + inc) * LOG2E; else nb[PAST + 8 + lane_] = -tot * LOG2E; }
    }
    __syncthreads();
    AttnSt16 S; attn_init16(S, nb[PAST + (((lane_ & 15) < SS) ? (lane_ & 15) : SS - 1)]);
    const LAS unsigned char* qpark = F.lds + SF_Q_OFF + F.wave * 1024;
#pragma unroll 1
    for (int tt = 0; tt < 4; ++tt) {
        const int tile = F.wave + 8 * tt; const int pgn = (tt + 1 < 4) ? PT[(tile + 8) >> 1] : 0;
        SF_WRITE(0, 0);
        if (tt + 1 < 4) SF_ISSUE(0, pgn, tile + 8, 0);
        SF_WRITE(1, 1);
        if (tt + 1 < 4) SF_ISSUE(1, pgn, tile + 8, 1);
        attn_tile16<false>(S, Kt, Vt, qpark, nb + 64 * tile, 64 * tile, PAST + (lane_ & 15), 64, lane_);
    }
#undef SF_WRITE
#undef SF_ISSUE
#undef SF_BASE
    q_prefetch(F, qid, qs);
    if (F.wave == 0) {
        for (int i = lane_; i < SF_WTILE / 16; i += 64) *(LAS v4u*)(Kt + i * 16) = (v4u){0u, 0u, 0u, 0u};
        const int kv = lane_ >> 3, c = lane_ & 7; const size_t g = ((size_t)MP + b * SS + kv) * TOKW + h * 64 + 8 * c;
        const v4u kr = *(const v4u*)(KB + g), vr = *(const v4u*)(VB + g);
        *(LAS v4u*)(Kt + c * KPB + kv * 16) = kr; *(LAS v4u*)(Vt + v_off<64>(kv, c)) = vr;
        attn_tile16<true>(S, Kt, Vt, qpark, nb + PAST, PAST, PAST + (lane_ & 15), SS, lane_);
    }
    __syncthreads();
    LAS float* mbuf = (LAS float*)(F.lds);
    merge_write16(S, mbuf, 8, F.wave, lane_);
    __syncthreads();
    { const int q = tid_ >> 6, d = tid_ & 63; const float o = merge_read<64>(mbuf, 8, q, d);
      const float o1 = __shfl_xor(o, 1);
      if ((d & 1) == 0) *(unsigned*)(MIXB + ((size_t)MP + b * SS + q) * D + h * 64 + d) = pk2(o, o1); }
}

constexpr int PL_E_OFF = 0, PL_E_PITCH = 256, PL_Y_OFF = 98304, PL_Y_PITCH = 272;
__device__ __forceinline__ void unit_pl(Frame& F, QState& qs, int qid, int j, int g) {
    int tid_ = F.tid, lane_ = F.lane; asm volatile("" : "+v"(tid_), "+v"(lane_));
    const bf16* ZB = (const bf16*)(F.ws + F_ZB); bf16* MIXB = (bf16*)(F.ws + F_MIXB); const bf16* WP = (const bf16*)(F.ws + F_WPOOL) + (size_t)g * 128 * 128;
    const float* state = F.in[4];
    const int w = 2 << g; const bool smp = j >= 128;
    LAS unsigned char* E = F.lds + PL_E_OFF;
    bf16x8 wf[4];
#pragma unroll
    for (int ks = 0; ks < 4; ++ks) wf[ks] = *(const bf16x8*)(WP + (size_t)(16 * F.wave + (lane_ & 15)) * 128 + 32 * ks + 8 * (lane_ >> 4));
    if (!smp) {
        const int b = j >> 4, s0 = (j & 15) * 128;
        v4u ev[5];
#pragma unroll
        for (int q = 0; q < 5; ++q) { const int i = tid_ + 512 * q, e = i >> 4, ch = i & 15, pos = s0 - 15 + e; ev[q] = (v4u){0u, 0u, 0u, 0u};
            if (i < 143 * 16 && pos >= 0) ev[q] = *(const v4u*)(ZB + ((size_t)b * PS + pos) * D + g * 128 + 8 * ch); }
#pragma unroll
        for (int q = 0; q < 5; ++q) { const int i = tid_ + 512 * q; if (i < 143 * 16) *(LAS v4u*)(E + (i >> 4) * PL_E_PITCH + (i & 15) * 16) = ev[q]; }
    } else {
        const int b0 = (j - 128) * 16;
        for (int i = tid_; i < 16 * 23 * 16; i += 512) { const int e = i >> 4, ch = i & 15, bi = e / 23, k = e % 23, b = b0 + bi; v4u v;
            if (k < 15) { const float* sp = state + ((size_t)b * 15 + k) * TOKW + g * 128 + 8 * ch; const f32x4 x0 = *(const f32x4*)sp, x1 = *(const f32x4*)(sp + 4);
                v.x = pk2(x0.x, x0.y); v.y = pk2(x0.z, x0.w); v.z = pk2(x1.x, x1.y); v.w = pk2(x1.z, x1.w); }
            else v = *(const v4u*)(ZB + ((size_t)MP + b * SS + (k - 15)) * D + g * 128 + 8 * ch);
            *(LAS v4u*)(E + e * PL_E_PITCH + ch * 16) = v; }
    }
    __syncthreads();
    {
        const int cp = tid_ & 63, rq = tid_ >> 6;
#define PL_SEG(W) do { _Pragma("unroll") for (int sg_ = 0; sg_ < 2; ++sg_) { const int tl0 = rq * 16 + sg_ * 8; const int e0 = smp ? (2 * rq + sg_) * 23 + 15 : 15 + tl0; \
            float x0[(W) + 7], x1[(W) + 7]; \
            _Pragma("unroll") for (int k = 0; k < (W) + 7; ++k) { const unsigned x = *(const LAS unsigned*)(E + (e0 - ((W) - 1) + k) * PL_E_PITCH + cp * 4); x0[k] = bf_lo(x); x1[k] = bf_hi(x); } \
            float s0 = 0.f, s1 = 0.f; \
            _Pragma("unroll") for (int k = 0; k < (W) - 1; ++k) { s0 += x0[k]; s1 += x1[k]; } \
            _Pragma("unroll") for (int i = 0; i < 8; ++i) { s0 += x0[(W) - 1 + i]; s1 += x1[(W) - 1 + i]; \
                float ic = 1.0f / (float)(W); if (!smp) { const int s = (j & 15) * 128 + tl0 + i; if (s + 1 < (W)) ic = 1.0f / (float)(s + 1); } \
                *(LAS unsigned*)(F.lds + PL_Y_OFF + (tl0 + i) * PL_Y_PITCH + cp * 4) = pk2(s0 * ic - x0[(W) - 1 + i], s1 * ic - x1[(W) - 1 + i]); \
                s0 -= x0[i]; s1 -= x1[i]; } } } while (0)
        if (g == 0) PL_SEG(2); else if (g == 1) PL_SEG(4); else if (g == 2) PL_SEG(8); else PL_SEG(16);
#undef PL_SEG
    }
    __syncthreads();
    q_prefetch(F, qid, qs);
    {
        const int r = lane_ & 15, kq = lane_ >> 4;
        const size_t obase = smp ? (size_t)MP + (j - 128) * 128 : (size_t)j * 128;
#pragma unroll
        for (int nb = 0; nb < 8; ++nb) { f32x4 acc = {0.f, 0.f, 0.f, 0.f};
#pragma unroll
            for (int ks = 0; ks < 4; ++ks) { const bf16x8 af = *(const LAS bf16x8*)(F.lds + PL_Y_OFF + (16 * nb + r) * PL_Y_PITCH + (32 * ks + 8 * kq) * 2);
                acc = __builtin_amdgcn_mfma_f32_16x16x32_bf16(wf[ks], af, acc, 0, 0, 0); }
            v2u o; o.x = pk2(acc[0], acc[1]); o.y = pk2(acc[2], acc[3]);
            *(v2u*)(MIXB + (obase + 16 * nb + r) * D + g * 128 + 16 * F.wave + 4 * kq) = o; }
    }
}

__device__ __forceinline__ void pool_state_job(Frame& F) {
    const bf16* ZB = (const bf16*)(F.ws + F_ZB); const float* state = F.in[4];
    constexpr int NP4 = PB * 15 * TOKW / 4, NS4 = SB * 15 * TOKW / 4;
    for (int i = blockIdx.x * 512 + F.tid; i < NP4 + NS4; i += F.G * 512) {
        if (i < NP4) { const int b = i / (15 * 128), r = (i / 128) % 15, c4 = i % 128; const v2u x = *(const v2u*)(ZB + ((size_t)b * PS + PS - 15 + r) * D + 4 * c4);
            *(f32x4*)(F.O.ps_p + (size_t)i * 4) = (f32x4){bf_lo(x.x), bf_hi(x.x), bf_lo(x.y), bf_hi(x.y)}; }
        else { const int k = i - NP4, b = k / (15 * 128), r = (k / 128) % 15, c4 = k % 128, e = r + SS; f32x4 o;
            if (e < 15) o = *(const f32x4*)(state + ((size_t)b * 15 + e) * TOKW + 4 * c4);
            else { const v2u x = *(const v2u*)(ZB + ((size_t)MP + b * SS + (e - 15)) * D + 4 * c4); o = (f32x4){bf_lo(x.x), bf_hi(x.x), bf_lo(x.y), bf_hi(x.y)}; }
            *(f32x4*)(F.O.ps_s + (size_t)k * 4) = o; }
    }
}

__device__ __forceinline__ void logf_job(Frame& F) {
    int tid_ = F.tid, lane_ = F.lane; asm volatile("" : "+v"(tid_), "+v"(lane_));
    const bf16* HB = (const bf16*)(F.ws + F_HB) + (size_t)1 * M * D; const float* WFG = (const float*)(F.ws + F_WFG); const float* SS = (const float*)(F.ws + F_SSH) + (size_t)1 * M * 16; const float* b_fg = F.in[26];
    const int c = lane_ & 15, rs = lane_ >> 4, kbase = 128 * F.wave + 8 * c;
    const bool b3 = (c & 8) != 0, b2 = (c & 4) != 0, b1 = (c & 2) != 0;
    f32x4 wv[8][2];
#pragma unroll
    for (int hh = 0; hh < 8; ++hh) { wv[hh][0] = *(const f32x4*)(WFG + (size_t)hh * D + kbase); wv[hh][1] = *(const f32x4*)(WFG + (size_t)hh * D + kbase + 4); }
    LAS float* part = (LAS float*)F.lds;
    constexpr int NSLOT = 17, NROW = 4 * NSLOT;
    const int nr = (M - (int)blockIdx.x + F.G - 1) / F.G;
#pragma unroll 1
    for (int i0 = 0; i0 < nr; i0 += NROW) {
        __syncthreads();
        v4u x[NSLOT];
#pragma unroll
        for (int sl = 0; sl < NSLOT; ++sl) { const int i = i0 + 4 * sl + rs; x[sl] = (v4u){0u, 0u, 0u, 0u};
            if (i < nr) x[sl] = *(const v4u*)(HB + (size_t)(blockIdx.x + F.G * i) * D + kbase); }
#pragma unroll
        for (int sl = 0; sl < NSLOT; ++sl) {
            const float e0 = bf_lo(x[sl].x), e1 = bf_hi(x[sl].x), e2 = bf_lo(x[sl].y), e3 = bf_hi(x[sl].y), e4 = bf_lo(x[sl].z), e5 = bf_hi(x[sl].z), e6 = bf_lo(x[sl].w), e7 = bf_hi(x[sl].w);
            float sh[8];
#pragma unroll
            for (int hh = 0; hh < 8; ++hh) sh[hh] = (e0 * wv[hh][0].x + e1 * wv[hh][0].y) + (e2 * wv[hh][0].z + e3 * wv[hh][0].w) + (e4 * wv[hh][1].x + e5 * wv[hh][1].y) + (e6 * wv[hh][1].z + e7 * wv[hh][1].w);
            float t4[4], t2[2];
#pragma unroll
            for (int hh = 0; hh < 4; ++hh) { const float keep = b3 ? sh[hh + 4] : sh[hh], send = b3 ? sh[hh] : sh[hh + 4]; t4[hh] = keep + __shfl_xor(send, 8); }
#pragma unroll
            for (int hh = 0; hh < 2; ++hh) { const float keep = b2 ? t4[hh + 2] : t4[hh], send = b2 ? t4[hh] : t4[hh + 2]; t2[hh] = keep + __shfl_xor(send, 4); }
            float t1; { const float keep = b1 ? t2[1] : t2[0], send = b1 ? t2[0] : t2[1]; t1 = keep + __shfl_xor(send, 2); }
            t1 += __shfl_xor(t1, 1);
            if ((c & 1) == 0) part[(F.wave * NROW + 4 * sl + rs) * 8 + (c >> 1)] = t1;
        }
        __syncthreads();
        for (int o = tid_; o < NROW * 8; o += NWAVES * 64) { const int il = o >> 3, hh = o & 7, i = i0 + il;
            if (i < nr) { const int row = blockIdx.x + F.G * i; float sum = 0.f;
#pragma unroll
                for (int w = 0; w < 8; ++w) sum += part[(w * NROW + il) * 8 + hh];
                const float xv = sum * row_rstd(SS, 16, row) + b_fg[hh]; const float r = fminf(xv, 0.f) - log1pf(__expf(-fabsf(xv)));
                if (row < MP) F.O.lf_p[(size_t)row * 8 + hh] = r; else F.O.lf_s[(size_t)(row - MP) * 8 + hh] = r; } }
    }
}
constexpr int N_PHASES = 11;
__global__ void __launch_bounds__(NWAVES * 64, 2) mega_fwd(Args args) {
    extern __shared__ __attribute__((aligned(16))) unsigned char lds[];
    Frame F;
    F.lds = (LAS unsigned char*)lds;
    F.MISC = (volatile LAS unsigned*)(F.lds + LCTL_OFF);
    F.tid = threadIdx.x; F.lane = F.tid & 63; F.wave = __builtin_amdgcn_readfirstlane(F.tid >> 6);
    F.G = gridDim.x; F.ws = args.ws; F.ctl = (gu32*)(args.ws + F_CTL);
#pragma unroll
    for (int i = 0; i < 28; ++i) F.in[i] = args.in[i];
    F.O = carve_out(args.out);
    for (int u = F.tid; u < (LDS_BYTES - LCTL_OFF) / 4; u += NWAVES * 64) ((LAS unsigned*)(F.lds + LCTL_OFF))[u] = 0u;
    __syncthreads();
    const int lo = args.ph_lo, hi = args.ph_hi;
    const bool one = (hi - lo) > 1;
    XcdBarrier bar; bar.bar = (unsigned*)(F.ctl + CW_BAR); bar.x = 0; bar.st = nullptr;
    if (one) bar = xcd_barrier_post((unsigned*)(F.ctl + CW_BAR), F.MISC + 8);
#define IN(k) (lo <= (k) && (k) < hi)
#define SEAM(k) do { if (IN(k) && IN((k) + 1)) xcd_barrier(bar); if (MK_TS >= 0 && (k) + 1 == MK_TS) ts0_ = __builtin_amdgcn_s_memrealtime(); if (MK_TS >= 0 && (k) == MK_TS) ts1_ = __builtin_amdgcn_s_memrealtime(); } while (0)
    unsigned long long ts0_ = (MK_TS == 0 || MK_TS == 99) ? __builtin_amdgcn_s_memrealtime() : 0ull, ts1_ = 0;
    unsigned char* ws = args.ws;
    bf16* XB = (bf16*)(ws + F_XB); bf16* MEMB = (bf16*)(ws + F_MEMB); bf16* ZB = (bf16*)(ws + F_ZB); bf16* Z1B = (bf16*)(ws + F_Z1B); bf16* MIXB = (bf16*)(ws + F_MIXB);
    bf16* HB = (bf16*)(ws + F_HB); float* HF = (float*)(ws + F_HF); bf16* ACTB = (bf16*)(ws + F_ACTB); bf16* KB = (bf16*)(ws + F_KB); bf16* VB = (bf16*)(ws + F_VB);
    bf16* MKB = (bf16*)(ws + F_MKB); bf16* MVB = (bf16*)(ws + F_MVB); float* SS0 = (float*)(ws + F_SS0); float* SSM = (float*)(ws + F_SSM); float* SSH = (float*)(ws + F_SSH);
    bf16* WIN0 = (bf16*)(ws + F_WIN0); bf16* W6 = (bf16*)(ws + F_W6); bf16* WOUT = (bf16*)(ws + F_WOUT); bf16* WGU = (bf16*)(ws + F_WGU); bf16* WDOWN = (bf16*)(ws + F_WDOWN); bf16* WMEM = (bf16*)(ws + F_WMEM);
    const size_t MD = (size_t)M * D;

    if (IN(0)) { _Pragma("unroll") for (int rep = 0; rep < ((MK_DUP >> 0) & 1) + 1; ++rep) { p0_prologue(F); } }
    SEAM(0);
    if (IN(1)) { _Pragma("unroll") for (int rep = 0; rep < ((MK_DUP >> 1) & 1) + 1; ++rep) {
        { pg8::Gemm g{XB, WIN0, MP, D, D}; pg8::StaticOrder S; S.init(MP, D, F.G, (int)blockIdx.x);
          fill_rstd_table(F.lds, S, SS0, 1, F.tid);
          epi::ScaleBf16 E{ZB, D, (const LAS float*)(F.lds + RT_OFF)};
          pg8::gemm_phase<epi::ScaleBf16, pg8::StaticOrder, true, true>(F.lds, g, S, E); }
        { const sg::EScale E{ZB, D, SS0, 1};
          for (int t = blockIdx.x; t < 256; t += F.G) sg::small_gemm(F, XB + (size_t)MP * D, WIN0, D, t >> 4, t & 15, MP, sg::MapId{}, E); }
        { const sg::EMemKV E{MKB, MVB, F.O.mv_p, SSM, 0};
          for (int t = blockIdx.x; t < 256; t += F.G) sg::small_gemm<2>(F, MEMB, WMEM, D, t >> 4, t & 15, 0, sg::MapId{}, E); }
    } }
    SEAM(1);
    if (IN(2)) { _Pragma("unroll") for (int rep = 0; rep < ((MK_DUP >> 2) & 1) + 1; ++rep) {
        pool_state_job(F);
        QState qs; for (int u = q_first(F, 0 + 2 * rep, qs); u < 1312; u = q_advance(F, qs)) { const int qid = 0 + 2 * rep;
            if (u < 768) { const int k = u / 3, r = u % 3;
                if (r == 0) { unit_pm(F, qs, qid, 0, k >> 5, (k >> 3) & 3, k & 7); if (MK_DUPU & 32) { __syncthreads(); QState dq_; unit_pm(F, dq_, 15, 0, k >> 5, (k >> 3) & 3, k & 7); } }
                else { const int i = 2 * k + r - 1; unit_sm(F, qs, qid, 0, i >> 2, i & 3); if (MK_DUPU & 16) { __syncthreads(); QState dq_; unit_sm(F, dq_, 15, 0, i >> 2, i & 3); } } }
            else { const int i = u - 768; unit_pl(F, qs, qid, i >> 2, i & 3); if (MK_DUPU & 64) { __syncthreads(); QState dq_; unit_pl(F, dq_, 15, i >> 2, i & 3); } } }
    } }
    SEAM(2);
    if (IN(3)) { _Pragma("unroll") for (int rep = 0; rep < ((MK_DUP >> 3) & 1) + 1; ++rep) {
        { pg8::Gemm g{MIXB, WOUT, MP, D, D}; pg8::StaticOrder S; S.init(MP, D, F.G, (int)blockIdx.x);
          epi::Resid E{XB, HB, nullptr, SSH};
          pg8::gemm_phase<epi::Resid, pg8::StaticOrder, true, true>(F.lds, g, S, E); }
        { const sg::EResid E{XB, HB, nullptr, SSH};
          for (int t = blockIdx.x; t < 256; t += F.G) sg::small_gemm(F, MIXB + (size_t)MP * D, WOUT, D, t >> 4, t & 15, MP, sg::MapId{}, E); }
    } }
    SEAM(3);
    if (IN(4)) { _Pragma("unroll") for (int rep = 0; rep < ((MK_DUP >> 4) & 1) + 1; ++rep) {
#if MK_NULLEPI
        if (rep == 0) { pg8::Gemm g{HB, WGU, M, 2 * FF, D}; pg8::StaticOrder S; S.init(M, 2 * FF, F.G, (int)blockIdx.x);
          epi::Null E{(float*)(ws + F_SSH + (size_t)3 * M * 16 * 4 - 1048576)};
          pg8::gemm_phase<epi::Null, pg8::StaticOrder, true, true>(F.lds, g, S, E); } else
#endif
        { pg8::Gemm g{HB, WGU, M, 2 * FF, D}; pg8::StaticOrder S; S.init(M, 2 * FF, F.G, (int)blockIdx.x);
          fill_rstd_table(F.lds, S, SSH, 16, F.tid);
          epi::Swiglu E{ACTB, (const LAS float*)(F.lds + RT_OFF)};
          pg8::gemm_phase<epi::Swiglu, pg8::StaticOrder, true, true>(F.lds, g, S, E); }
        { pg8::Gemm g{MEMB, WMEM + (size_t)D * D, MEMROWS, D, D}; pg8::StaticOrder S; S.init(MEMROWS, D, F.G, (int)((blockIdx.x + 40) % F.G));
          fill_rstd_table(F.lds, S, SSM, 1, F.tid);
          epi::MemKV E{MKB, MVB, F.O.mv_p, (const LAS float*)(F.lds + RT_OFF), 1};
          pg8::gemm_phase<epi::MemKV, pg8::StaticOrder, true, true>(F.lds, g, S, E); }
    } }
    SEAM(4);
    if (IN(5)) { _Pragma("unroll") for (int rep = 0; rep < ((MK_DUP >> 5) & 1) + 1; ++rep) {
        { pg8::Gemm g{ACTB, WDOWN, MP, D, FF}; pg8::StaticOrder S; S.init(MP, D, F.G, (int)blockIdx.x);
          epi::Resid E{HB, HB + MD, nullptr, SSH + (size_t)M * 16};
          pg8::gemm_phase<epi::Resid, pg8::StaticOrder, true, true>(F.lds, g, S, E); }
        { const sg::EResid E{HB, HB + MD, nullptr, SSH + (size_t)M * 16};
          for (int t = blockIdx.x; t < 256; t += F.G) sg::small_gemm(F, ACTB + (size_t)MP * FF, WDOWN, FF, t >> 4, t & 15, MP, sg::MapId{}, E); }
    } }
    SEAM(5);
    if (IN(6)) { _Pragma("unroll") for (int rep = 0; rep < ((MK_DUP >> 6) & 1) + 1; ++rep) {
        { pg8::Gemm g{HB + MD, W6, MP, 2 * D, D}; pg8::StaticOrder S; S.init(MP, 2 * D, F.G, (int)blockIdx.x);
          if (F.tid < 64) ((LAS float*)(F.lds + RT_OFF))[2048 + F.tid] = F.in[24][F.tid];
          fill_rstd_table(F.lds, S, SSH + (size_t)M * 16, 16, F.tid);
          epi::KVQ E{KB, VB, Z1B, F.O.k_p, F.O.k_s, F.O.v_p, F.O.v_s, F.in[24], (const LAS float*)(F.lds + RT_OFF)};
          pg8::gemm_phase<epi::KVQ, pg8::StaticOrder, true, true>(F.lds, g, S, E); }
        { const sg::EKVQ E{KB, VB, Z1B, F.O.k_s, F.O.v_s, F.in[24], SSH + (size_t)M * 16};
          for (int t = blockIdx.x; t < 256; t += F.G) sg::small_gemm<2>(F, HB + MD + (size_t)MP * D, W6, D, t >> 5, t & 31, MP, sg::MapHead64{}, E); }
        logf_job(F); if (MK_DUPS & 1) logf_job(F);
#if MK_STREAM_PROBE
        {
            f32x4 a0 = {0.f, 0.f, 0.f, 0.f}, a1 = a0, a2 = a0, a3 = a0; const size_t n = (size_t)2560 * 128 * 512 / 4, stride = (size_t)F.G * 512;
            for (int w = 0; w < 2; ++w) { const f32x4* p = (const f32x4*)F.in[5 + w];
                for (size_t i = (size_t)blockIdx.x * 512 + F.tid; i + 7 * stride < n; i += 8 * stride) {
                    const f32x4 x0 = p[i], x1 = p[i + stride], x2 = p[i + 2 * stride], x3 = p[i + 3 * stride], x4 = p[i + 4 * stride], x5 = p[i + 5 * stride], x6 = p[i + 6 * stride], x7 = p[i + 7 * stride];
                    a0 += x0 + x4; a1 += x1 + x5; a2 += x2 + x6; a3 += x3 + x7; } }
            const f32x4 s = (a0 + a1) + (a2 + a3);
            ((float*)(F.ws + F_SSH + (size_t)3 * M * 16 * 4 - 1048576))[blockIdx.x * 512 + F.tid] = s.x + s.y + s.z + s.w;
        }
#endif
    } }
    SEAM(6);
    if (IN(7)) { _Pragma("unroll") for (int rep = 0; rep < ((MK_DUP >> 7) & 1) + 1; ++rep) {
        QState qs; for (int u = q_first(F, 1 + 2 * rep, qs); u < 2304; u = q_advance(F, qs)) { const int qid = 1 + 2 * rep;
            if (u < 1536) { const int k = u / 3, r = u % 3;
                if (r < 2) { const int i = 2 * k + r; unit_sf(F, qs, qid, i >> 3, i & 7); if (MK_DUPU & 1) { __syncthreads(); QState dq_; unit_sf(F, dq_, 15, i >> 3, i & 7); } }
                else { const int i = k; unit_pf(F, qs, qid, (i & 63) >> 3, i & 7, 7 - (i >> 6)); if (MK_DUPU & 2) { __syncthreads(); QState dq_; unit_pf(F, dq_, 15, (i & 63) >> 3, i & 7, 7 - (i >> 6)); } } }
            else { const int v = u - 1536, k = v / 3, r = v % 3;
                if (r < 2) { const int i = 2 * k + r; unit_sm(F, qs, qid, 1, i >> 2, i & 3); if (MK_DUPU & 4) { __syncthreads(); QState dq_; unit_sm(F, dq_, 15, 1, i >> 2, i & 3); } }
                else { unit_pm(F, qs, qid, 1, k >> 5, (k >> 3) & 3, k & 7); if (MK_DUPU & 8) { __syncthreads(); QState dq_; unit_pm(F, dq_, 15, 1, k >> 5, (k >> 3) & 3, k & 7); } } } }
    } }
    SEAM(7);
    if (IN(8)) { _Pragma("unroll") for (int rep = 0; rep < ((MK_DUP >> 8) & 1) + 1; ++rep) {
        { pg8::Gemm g{MIXB + MD, WOUT + (size_t)D * D, MP, D, D}; pg8::StaticOrder S; S.init(MP, D, F.G, (int)blockIdx.x);
          epi::Resid E{HB + MD, HB + 2 * MD, nullptr, SSH + (size_t)2 * M * 16};
          pg8::gemm_phase<epi::Resid, pg8::StaticOrder, true, true>(F.lds, g, S, E); }
        { const sg::EResid E{HB + MD, HB + 2 * MD, nullptr, SSH + (size_t)2 * M * 16};
          for (int t = blockIdx.x; t < 256; t += F.G) sg::small_gemm(F, MIXB + MD + (size_t)MP * D, WOUT + (size_t)D * D, D, t >> 4, t & 15, MP, sg::MapId{}, E); }
    } }
    SEAM(8);
#if MK_XBAR
    if (one) { for (int i = 0; i < MK_XBAR; ++i) xcd_barrier(bar); }
#endif
    if (IN(9)) { _Pragma("unroll") for (int rep = 0; rep < ((MK_DUP >> 9) & 1) + 1; ++rep) { pg8::Gemm g{HB + 2 * MD, WGU + (size_t)2 * FF * D, M, 2 * FF, D}; pg8::StaticOrder S; S.init(M, 2 * FF, F.G, (int)blockIdx.x);
        fill_rstd_table(F.lds, S, SSH + (size_t)2 * M * 16, 16, F.tid);
        epi::Swiglu E{ACTB + (size_t)M * FF, (const LAS float*)(F.lds + RT_OFF)};
        pg8::gemm_phase<epi::Swiglu, pg8::StaticOrder, true, true>(F.lds, g, S, E); } }
    SEAM(9);
    if (IN(10)) { _Pragma("unroll") for (int rep = 0; rep < ((MK_DUP >> 10) & 1) + 1; ++rep) {
        { pg8::Gemm g{ACTB + (size_t)M * FF, WDOWN + (size_t)D * FF, MP, D, FF}; pg8::StaticOrder S; S.init(MP, D, F.G, (int)blockIdx.x);
          epi::Resid E{HB + 2 * MD, nullptr, F.O.y_p, nullptr};
          pg8::gemm_phase<epi::Resid, pg8::StaticOrder, true, true>(F.lds, g, S, E); }
        { const sg::EResid E{HB + 2 * MD, nullptr, F.O.y_p, nullptr};
          for (int t = blockIdx.x; t < 256; t += F.G) sg::small_gemm(F, ACTB + (size_t)M * FF + (size_t)MP * FF, WDOWN + (size_t)D * FF, FF, t >> 4, t & 15, MP, sg::MapId{}, E); }
    } }
#if MK_TS >= 0
    if (MK_TS == 99) ts1_ = __builtin_amdgcn_s_memrealtime();
    if (blockIdx.x == 0 && F.tid == 0) { asm volatile("s_waitcnt vmcnt(0)" ::: "memory"); args.out[0] = (float)(((ts1_ - ts0_) / 2500ull) * 25ull) * 1.0e6f; }
#endif
#undef IN
#undef SEAM
}

#ifndef MK_DEBUG
#define MK_DEBUG 0
#endif
#ifndef MK_PER_PHASE
#define MK_PER_PHASE 0
#endif
static int mk_grid() {
    static int grid = 0;
    if (grid == 0) {
        int dev = 0, cus = 0, per_cu = 0;
        if (hipGetDevice(&dev) != hipSuccess || hipDeviceGetAttribute(&cus, hipDeviceAttributeMultiprocessorCount, dev) != hipSuccess) { fprintf(stderr, "kernel_launch: device query failed\n"); grid = -1; return grid; }
        if (hipFuncSetAttribute((const void*)mega_fwd, hipFuncAttributeMaxDynamicSharedMemorySize, LDS_BYTES) != hipSuccess) { fprintf(stderr, "kernel_launch: hipFuncSetAttribute failed\n"); grid = -1; return grid; }
        if (hipOccupancyMaxActiveBlocksPerMultiprocessor(&per_cu, (const void*)mega_fwd, NWAVES * 64, LDS_BYTES) != hipSuccess || per_cu < 1) fprintf(stderr, "kernel_launch: occupancy query reports %d\n", per_cu);
        (void)hipGetLastError();
        grid = cus;
    }
    return grid;
}
static void mk_launch(void* const* d_in, float* out, unsigned char* fws, hipStream_t stream) {
    const int grid = mk_grid(); if (grid <= 0) return;
    (void)hipMemsetAsync(fws + F_CTL, 0, CTL_ZERO_BYTES, stream);
    Args a{};
    for (int i = 0; i < 28; ++i) a.in[i] = (const float*)d_in[i];
    a.out = out; a.ws = fws;
#if MK_PER_PHASE
    for (int p = 0; p < N_PHASES; ++p) { a.ph_lo = p; a.ph_hi = p + 1; hipLaunchKernelGGL(mega_fwd, dim3(grid), dim3(NWAVES * 64), LDS_BYTES, stream, a); }
#else
    a.ph_lo = 0; a.ph_hi = N_PHASES; hipLaunchKernelGGL(mega_fwd, dim3(grid), dim3(NWAVES * 64), LDS_BYTES, stream, a);
#endif
    const hipError_t le = hipPeekAtLastError();
    if (le != hipSuccess) fprintf(stderr, "kernel_launch: launch failed: %s\n", hipGetErrorName(le));
}
#if MK_DEBUG
namespace dbg {
constexpr int MAXST = 40;
__global__ void k_cmp(const void* f, int is_bf16, int ldf, const float* n, int ldn, int rows, int cols, double* acc, int st) {
    double d2 = 0.0, n2 = 0.0;
    const size_t tot = (size_t)rows * cols;
    for (size_t i = (size_t)blockIdx.x * blockDim.x + threadIdx.x; i < tot; i += (size_t)gridDim.x * blockDim.x) {
        const size_t r = i / cols; const int c = (int)(i % cols);
        float fv; if (is_bf16) { const unsigned short u = ((const unsigned short*)f)[r * ldf + c]; fv = __builtin_bit_cast(float, (unsigned)u << 16); } else fv = ((const float*)f)[r * ldf + c];
        const float nv_ = n[r * ldn + c];
        double d = (double)fv - (double)nv_; if (!(fv == fv)) d = 1e30;
        d2 += d * d; n2 += (double)nv_ * (double)nv_;
    }
    for (int o = 32; o > 0; o >>= 1) { d2 += __shfl_xor(d2, o); n2 += __shfl_xor(n2, o); }
    if ((threadIdx.x & 63) == 0) { atomicAdd(acc + 2 * st, d2); atomicAdd(acc + 2 * st + 1, n2); }
}
__global__ void k_verdict(const double* acc, int nst, double tol, float* out) {
    if (threadIdx.x != 0 || blockIdx.x != 0) return;
    for (int s = 0; s < nst; ++s) { const double r = acc[2 * s] / (acc[2 * s + 1] + 1e-300);
        if (!(r <= tol)) { int c = 13; if (r == r && r < 1e4) { c = (int)floor(log10(r + 1e-300)) + 9; if (c < 0) c = 0; if (c > 13) c = 13; }
            out[0] = (float)((10.0 + s) * pow(10.0, 5.0 + c)); return; } }
}
template <int MAP> __global__ void k_expw(const float* W, int ldw, int K, int Nphys, const float* gain, const float* cscale, float* E) {
    const size_t tot = (size_t)Nphys * K;
    for (size_t i = (size_t)blockIdx.x * blockDim.x + threadIdx.x; i < tot; i += (size_t)gridDim.x * blockDim.x) {
        const int p = (int)(i / K), k = (int)(i % K); const int sc = src_col<MAP>(p);
        E[i] = W[(size_t)k * ldw + sc] * (gain ? gain[k] : 1.0f) * (cscale ? cscale[sc] : 1.0f);
    }
}
}
#endif

extern "C" void kernel_launch(void* const* d_in, const int* in_sizes, int n_in, void* d_out, int out_size, void* d_ws, size_t ws_size, hipStream_t stream) {
    unsigned char* ws = (unsigned char*)d_ws;
#if !MK_DEBUG
    mk_launch(d_in, (float*)d_out, ws, stream);
#else
    size_t off = al(F_END); float* alt = (float*)(ws + off); off += al((size_t)out_size * 4);
    double* acc = (double*)(ws + off); off += 4096;
    float* nws = (float*)(ws + off); size_t nused = 0; (void)nv::carve_ws(nws, nused); off += al(nused * 4);
    nv::Snap sn; const size_t MDf = (size_t)M * D;
    float* sp = (float*)(ws + off);
    sn.Z[0] = sp; sn.Z[1] = sp + MDf; sn.MIX[0] = sp + 2 * MDf; sn.MIX[1] = sp + 3 * MDf; sn.HA[0] = sp + 4 * MDf; sn.HA[1] = sp + 5 * MDf; sn.HD0 = sp + 6 * MDf; sn.KN = sp + 7 * MDf; sn.V = sn.KN + (size_t)M * TOKW;
    off += al((7 * MDf + 2 * (size_t)M * TOKW) * 4);
    float* ew = (float*)(ws + off); off += al((size_t)2 * FF * D * 4);
    if (off > ws_size) { fprintf(stderr, "debug layout needs %zu bytes, ws has %zu\n", off, ws_size); return; }
    nv::run(d_in, (float*)d_out, nws, stream, &sn);
    mk_launch(d_in, alt, ws, stream);
    (void)hipMemsetAsync(acc, 0, 4096, stream);
    OutPtrs A = carve_out(alt), R = carve_out((float*)d_out);
    int st = 0;
#define CMP(f, isb, ldf, n, ldn, rows, cols) do { hipLaunchKernelGGL(dbg::k_cmp, dim3(1024), dim3(256), 0, stream, (const void*)(f), (isb), (ldf), (const float*)(n), (ldn), (rows), (cols), acc, st); ++st; } while (0)
    const size_t MD2 = (size_t)M * D * 2;
#define WCHK(MAP, W, ldw, K, N, gain, cs, WT) do { hipLaunchKernelGGL(dbg::k_expw<MAP>, dim3(1024), dim3(256), 0, stream, (const float*)(W), (ldw), (K), (N), (const float*)(gain), (const float*)(cs), ew); CMP((WT), 1, (K), ew, (K), (N), (K)); } while (0)
    { const float* g_mix = (const float*)d_in[10]; const float* w_in = (const float*)d_in[11]; const float* w_out = (const float*)d_in[12]; const float* g_ffn = (const float*)d_in[13]; const float* w_gu = (const float*)d_in[14];
      const float* w_down = (const float*)d_in[15]; const float* w_pool = (const float*)d_in[20]; const float* pscale = (const float*)d_in[21]; const float* g_kv = (const float*)d_in[22]; const float* w_kv = (const float*)d_in[23];
      WCHK(MAP_ID, w_pool, 128, 128, 128, nullptr, pscale, ws + F_WPOOL);
      WCHK(MAP_ID, w_pool + 3 * 128 * 128, 128, 128, 128, nullptr, pscale + 3 * 128, ws + F_WPOOL + 3 * 128 * 128 * 2);
      WCHK(MAP_ID, w_out + (size_t)D * D, D, D, D, nullptr, nullptr, ws + F_WOUT + (size_t)D * D * 2);
      WCHK(MAP_SWIGLU, w_gu + (size_t)D * 2 * FF, 2 * FF, D, 2 * FF, g_ffn + D, nullptr, ws + F_WGU + (size_t)2 * FF * D * 2);
      WCHK(MAP_ID, w_down + (size_t)FF * D, D, FF, D, nullptr, nullptr, ws + F_WDOWN + (size_t)D * FF * 2);
      WCHK(MAP_HEAD64, w_kv, D, D, D, g_kv, nullptr, ws + F_W6);
      WCHK(MAP_HEAD64, w_in + (size_t)D * D, D, D, D, g_mix + D, nullptr, ws + F_W6 + (size_t)D * D * 2); }
    CMP(ws + F_ZB, 1, D, sn.Z[0], D, M, D);
    CMP(A.mv_p, 0, TOKW, R.mv_p, TOKW, 2 * MEMROWS, TOKW);
    CMP(A.mk_p, 0, TOKW, R.mk_p, TOKW, 2 * MEMROWS, TOKW);
    CMP(ws + F_MIXB, 1, D, sn.MIX[0], D, MP, 128);
    CMP(ws + F_MIXB + 128 * 2, 1, D, sn.MIX[0] + 128, D, MP, 384);
    CMP(ws + F_MIXB + (size_t)MP * D * 2, 1, D, sn.MIX[0] + (size_t)MP * D, D, MS, TOKW);
    CMP(ws + F_MIXB + TOKW * 2, 1, D, sn.MIX[0] + TOKW, D, MP, TOKW);
    CMP(ws + F_MIXB + (size_t)MP * D * 2 + TOKW * 2, 1, D, sn.MIX[0] + (size_t)MP * D + TOKW, D, MS, TOKW);
    CMP(A.ps_p, 0, TOKW, R.ps_p, TOKW, PB * 15, TOKW);
    CMP(A.ps_s, 0, TOKW, R.ps_s, TOKW, SB * 15, TOKW);
    CMP(ws + F_HB, 1, D, sn.HA[0], D, M, D);
    CMP(ws + F_HB + MD2, 1, D, sn.HD0, D, M, D);
    CMP(ws + F_KB, 1, TOKW, sn.KN, TOKW, M, TOKW);
    CMP(ws + F_VB, 1, TOKW, sn.V, TOKW, M, TOKW);
    CMP(A.k_p, 0, TOKW, R.k_p, TOKW, MP, TOKW);
    CMP(A.v_p, 0, TOKW, R.v_p, TOKW, MP, TOKW);
    CMP(A.k_s, 0, TOKW, R.k_s, TOKW, MS, TOKW);
    CMP(A.v_s, 0, TOKW, R.v_s, TOKW, MS, TOKW);
    CMP(A.lf_p, 0, 8, R.lf_p, 8, MP, 8);
    CMP(A.lf_s, 0, 8, R.lf_s, 8, MS, 8);
    CMP(ws + F_Z1B, 1, D, sn.Z[1], D, M, D);
    CMP(ws + F_MIXB + MD2, 1, D, sn.MIX[1], D, MP, TOKW);
    CMP(ws + F_MIXB + MD2 + (size_t)MP * D * 2, 1, D, sn.MIX[1] + (size_t)MP * D, D, MS, TOKW);
    CMP(ws + F_MIXB + MD2 + TOKW * 2, 1, D, sn.MIX[1] + TOKW, D, MP, TOKW);
    CMP(ws + F_MIXB + MD2 + (size_t)MP * D * 2 + TOKW * 2, 1, D, sn.MIX[1] + (size_t)MP * D + TOKW, D, MS, TOKW);
    CMP(ws + F_HB + MD2 * 2, 1, D, sn.HA[1], D, M, D);
    CMP(A.y_p, 0, D, R.y_p, D, MP, D);
    CMP(A.y_s, 0, D, R.y_s, D, MS, D);
#undef CMP
    hipLaunchKernelGGL(dbg::k_verdict, dim3(1), dim3(64), 0, stream, acc, st, (double)MK_DEBUG_TOL, (float*)d_out);
#endif
}
```

```cpp
#include <hip/hip_runtime.h>
#include <cstdint>
#include <cstdio>
#include <cmath>
#define MK_DEBUG 0
#define MK_PER_PHASE 0
#define MK_DEBUG_TOL 1e-3
#define MK_DUP 0
#define MK_DUPU 0
#define MK_STREAM_PROBE 0
#define MK_XBAR 0
#define MK_NULLEPI 0
#define MK_DUPS 0
#define MK_TS -1
namespace pg8 {
#define PG8_LAS __attribute__((address_space(3)))
typedef unsigned short bf16_t;
typedef short bf16x8 __attribute__((ext_vector_type(8)));
typedef float f32x4 __attribute__((ext_vector_type(4)));
typedef unsigned u32x4 __attribute__((ext_vector_type(4)));
constexpr int BM = 256, BK = 64, HALF = 128, HTB = HALF * BK * 2  , STAGE_BYTES = 8 * HTB, NXCD = 8, WGM = 8;

__host__ __device__ __forceinline__ int lds_byte(int r, int c) { const int st = (r >> 4) * 2 + (c >> 5), rr = r & 15, cc = c & 31, ob = rr * 64 + cc * 2; return st * 1024 + (ob ^ (((ob >> 9) & 1) << 5)); }
__host__ __device__ __forceinline__ void stage_rc(int b, int& R, int& C) { const int st = b / 1024, sb = b % 1024, swz = sb ^ (((sb >> 9) & 1) << 5); R = (st >> 1) * 16 + swz / 64; C = (st & 1) * 32 + (swz % 64) / 2; }
__host__ __device__ __forceinline__ int perm32(int rho) { const int n = rho >> 4, i = rho & 15; return 8 * (i >> 2) + 4 * n + (i & 3); }

struct Unit { int pm, pn, i; };
struct Gemm { const bf16_t* A; const bf16_t* Bt; int M, N, K; };

struct StaticOrder {
    int nM, nN, nwg, G, c;
    __host__ __device__ void init(int M, int N, int G_, int c_) { nM = M / BM; nN = N / BM; nwg = nM * nN; G = G_; c = c_; }
    __host__ __device__ bool next(int i, Unit& u) const {
        const long L = (long)i * G + c; if (L >= nwg) return false;
        int wgid = (int)L; { const int q = nwg / NXCD, r = nwg % NXCD, xcd = wgid % NXCD, off = wgid / NXCD; wgid = (xcd < r ? xcd * (q + 1) : r * (q + 1) + (xcd - r) * q) + off; }
        const int nig = WGM * nN, gid = wgid / nig, fm = gid * WGM, gsz = (nM - fm) < WGM ? (nM - fm) : WGM;
        u.pm = fm + ((wgid % nig) % gsz); u.pn = (wgid % nig) / gsz; u.i = i; return true;
    }
    __device__ __forceinline__ void a_ready(const Unit&) const {}
    __device__ __forceinline__ void done(const Unit&) const {}
};

__device__ __forceinline__ unsigned cvt_pk_bf16(float lo, float hi) { unsigned r; asm volatile("v_cvt_pk_bf16_f32 %0, %1, %2" : "=v"(r) : "v"(lo), "v"(hi)); return r; }
typedef float f32x2 __attribute__((ext_vector_type(2)));
template <class Epi, class Sched, bool ALIGN_EPI = false, bool SP2 = false>
__device__ __forceinline__ void gemm_phase(PG8_LAS unsigned char* lds, const Gemm g, const Sched& S, const Epi& E) {
    int tid = threadIdx.x; asm volatile("" : "+v"(tid));
    const int wid = __builtin_amdgcn_readfirstlane(tid >> 6), lane = tid & 63, wr = wid >> 2, wc = wid & 3, fr = lane & 15, fq = lane >> 4;
    const int K = g.K, nt = K / BK;
    unsigned voffA[2], voffB[2];
#pragma unroll
    for (int i = 0; i < 2; ++i) { int R, C; stage_rc(tid * 16 + i * 8192, R, C); const int Rb = Epi::PERM ? ((R & ~31) + perm32(R & 31)) : R;
        voffA[i] = (unsigned)(R * K + C) * 2u; voffB[i] = (unsigned)(Rb * K + C) * 2u; }
    const size_t kstep = (size_t)(BK * 2);
    const size_t hstep = (size_t)HALF * K * 2;
    const size_t tstep = 2 * hstep;
    const unsigned ldsw = (unsigned)wid * 1024u;
    const int aoff = lds_byte(wr * 64 + fr, fq * 8), boff = lds_byte(wc * 32 + fr, fq * 8);
#define PG8_SA(b, h) (((b) * 2 + (h)) * HTB)
#define PG8_SB(b, h) ((4 + (b) * 2 + (h)) * HTB)
#define PG8_STAGE(bufoff, gbase, voff) do { _Pragma("unroll") for (int _i = 0; _i < 2; ++_i) \
        __builtin_amdgcn_global_load_lds((const unsigned*)((const char*)(gbase) + (voff)[_i]), (PG8_LAS unsigned*)(lds + (bufoff) + ldsw + _i * 8192), 16, 0, 0); } while (0)
#define PG8_LDA(dst, b, h) do { _Pragma("unroll") for (int m = 0; m < 4; ++m) _Pragma("unroll") for (int k = 0; k < 2; ++k) dst[m][k] = *(const PG8_LAS bf16x8*)(lds + PG8_SA(b, h) + aoff + m * 2048 + k * 1024); } while (0)
#define PG8_LDB(dst, b, h) do { _Pragma("unroll") for (int n = 0; n < 2; ++n) _Pragma("unroll") for (int k = 0; k < 2; ++k) dst[n][k] = *(const PG8_LAS bf16x8*)(lds + PG8_SB(b, h) + boff + n * 2048 + k * 1024); } while (0)
#define PG8_MMA(ai, bj, At, Bt) do { __builtin_amdgcn_s_setprio(1); _Pragma("unroll") for (int m = 0; m < 4; ++m) _Pragma("unroll") for (int n = 0; n < 2; ++n) _Pragma("unroll") for (int k = 0; k < 2; ++k) \
        acc[ai][bj][m][n] = __builtin_amdgcn_mfma_f32_16x16x32_bf16(Bt[n][k], At[m][k], acc[ai][bj][m][n], 0, 0, 0); __builtin_amdgcn_s_setprio(0); } while (0)
#define PG8_WAIT_V(n) asm volatile("s_waitcnt vmcnt(" #n ")" ::: "memory")
#define PG8_WAIT_L(n) asm volatile("s_waitcnt lgkmcnt(" #n ")" ::: "memory")
#define PG8_BAR __builtin_amdgcn_s_barrier()
#define PG8_SCHED __builtin_amdgcn_sched_barrier(0)
    Unit cur, nxt; int ui = 0;
    if (!S.next(0, cur)) return;
    f32x4 acc[2][2][4][2];
#pragma unroll
    for (int a = 0; a < 2; ++a)
#pragma unroll
        for (int b = 0; b < 2; ++b)
#pragma unroll
            for (int m = 0; m < 4; ++m)
#pragma unroll
                for (int n = 0; n < 2; ++n) acc[a][b][m][n] = (f32x4){0.f, 0.f, 0.f, 0.f};
    bf16x8 At[4][2], B0[2][2], B1[2][2];
    const char* cA = (const char*)g.A + (size_t)cur.pm * tstep; const char* cB = (const char*)g.Bt + (size_t)cur.pn * tstep;
    S.a_ready(cur);
    if constexpr (SP2) {
        PG8_STAGE(PG8_SB(0, 0), cB, voffB); PG8_STAGE(PG8_SB(0, 1), cB + hstep, voffB); PG8_STAGE(PG8_SA(0, 0), cA, voffA); PG8_STAGE(PG8_SA(0, 1), cA + hstep, voffA);
        if (wr == 1) PG8_BAR;
        PG8_WAIT_V(2); PG8_BAR;
        PG8_STAGE(PG8_SB(1, 0), cB + kstep, voffB); PG8_STAGE(PG8_SA(1, 0), cA + kstep, voffA); PG8_STAGE(PG8_SB(1, 1), cB + hstep + kstep, voffB);
        PG8_WAIT_V(6); PG8_BAR;
    } else {
        PG8_STAGE(PG8_SB(0, 0), cB, voffB); PG8_STAGE(PG8_SA(0, 0), cA, voffA); PG8_STAGE(PG8_SB(0, 1), cB + hstep, voffB); PG8_STAGE(PG8_SA(0, 1), cA + hstep, voffA);
        if (wr == 1) PG8_BAR;
        PG8_WAIT_V(4); PG8_BAR;
        PG8_STAGE(PG8_SB(1, 0), cB + kstep, voffB); PG8_STAGE(PG8_SA(1, 0), cA + kstep, voffA); PG8_STAGE(PG8_SB(1, 1), cB + hstep + kstep, voffB);
        PG8_WAIT_V(6); PG8_BAR;
    }
    for (;;) {
        const bool has_next = S.next(ui + 1, nxt);
        const char* nA = has_next ? (const char*)g.A + (size_t)nxt.pm * tstep : cA; const char* nB = has_next ? (const char*)g.Bt + (size_t)nxt.pn * tstep : cB;
        for (int t = 0; t < nt; t += 2) {
            const bool last = (t == nt - 2);
            const char* a1 = cA + (size_t)(t + 1) * kstep;
            const char* a2 = last ? nA : cA + (size_t)(t + 2) * kstep; const char* b2 = last ? nB : cB + (size_t)(t + 2) * kstep;
            const char* a3 = a2 + kstep; const char* b3 = b2 + kstep;
            if (last && has_next) S.a_ready(nxt);
            if constexpr (SP2) {
            PG8_LDB(B0, 0, 0); PG8_LDB(B1, 0, 1); PG8_SCHED; PG8_LDA(At, 0, 0); PG8_STAGE(PG8_SA(1, 1), a1 + hstep, voffA);
            PG8_WAIT_V(8); PG8_WAIT_L(0); PG8_BAR; PG8_MMA(0, 0, At, B0); PG8_MMA(0, 1, At, B1); PG8_BAR; PG8_SCHED;
            PG8_LDA(At, 0, 1); PG8_STAGE(PG8_SB(0, 0), b2, voffB); PG8_STAGE(PG8_SB(0, 1), b2 + hstep, voffB); PG8_STAGE(PG8_SA(0, 0), a2, voffA);
            PG8_WAIT_V(8); PG8_WAIT_L(0); PG8_BAR; PG8_MMA(1, 0, At, B0); PG8_MMA(1, 1, At, B1); PG8_BAR; PG8_SCHED;
            PG8_LDB(B0, 1, 0); PG8_LDB(B1, 1, 1); PG8_SCHED; PG8_LDA(At, 1, 0); PG8_STAGE(PG8_SA(0, 1), a2 + hstep, voffA);
            PG8_WAIT_V(8); PG8_WAIT_L(0); PG8_BAR; PG8_MMA(0, 0, At, B0); PG8_MMA(0, 1, At, B1); PG8_BAR; PG8_SCHED;
            PG8_LDA(At, 1, 1); PG8_STAGE(PG8_SB(1, 0), b3, voffB); PG8_STAGE(PG8_SB(1, 1), b3 + hstep, voffB); PG8_STAGE(PG8_SA(1, 0), a3, voffA);
            PG8_WAIT_V(8); PG8_WAIT_L(0); PG8_BAR; PG8_MMA(1, 0, At, B0); PG8_MMA(1, 1, At, B1); PG8_BAR; PG8_SCHED;
            } else {
            PG8_LDB(B0, 0, 0); PG8_SCHED; PG8_LDA(At, 0, 0); PG8_STAGE(PG8_SA(1, 1), a1 + hstep, voffA);
            PG8_WAIT_L(8); PG8_BAR; PG8_WAIT_L(0); PG8_MMA(0, 0, At, B0); PG8_BAR; PG8_SCHED;
            PG8_LDB(B1, 0, 1); PG8_STAGE(PG8_SB(0, 0), b2, voffB);
            PG8_BAR; PG8_WAIT_L(0); PG8_MMA(0, 1, At, B1); PG8_BAR;
            PG8_LDA(At, 0, 1); PG8_STAGE(PG8_SA(0, 0), a2, voffA);
            PG8_BAR; PG8_WAIT_L(0); PG8_MMA(1, 0, At, B0); PG8_BAR; PG8_SCHED;
            PG8_STAGE(PG8_SB(0, 1), b2 + hstep, voffB);
            PG8_WAIT_V(6); PG8_BAR; PG8_MMA(1, 1, At, B1); PG8_BAR;
            PG8_LDB(B0, 1, 0); PG8_SCHED; PG8_LDA(At, 1, 0); PG8_STAGE(PG8_SA(0, 1), a2 + hstep, voffA);
            PG8_WAIT_L(8); PG8_BAR; PG8_WAIT_L(0); PG8_MMA(0, 0, At, B0); PG8_BAR; PG8_SCHED;
            PG8_LDB(B1, 1, 1); PG8_STAGE(PG8_SB(1, 0), b3, voffB);
            PG8_BAR; PG8_WAIT_L(0); PG8_MMA(0, 1, At, B1); PG8_BAR;
            PG8_LDA(At, 1, 1); PG8_STAGE(PG8_SA(1, 0), a3, voffA);
            PG8_BAR; PG8_WAIT_L(0); PG8_MMA(1, 0, At, B0); PG8_BAR; PG8_SCHED;
            PG8_STAGE(PG8_SB(1, 1), b3 + hstep, voffB);
            PG8_WAIT_V(6); PG8_BAR; PG8_MMA(1, 1, At, B1); PG8_BAR;
            }
        }
        if constexpr (ALIGN_EPI) { if (wr == 0) PG8_BAR; }
        if constexpr (!Epi::AFTER_DRAIN) { E(acc, cur, wr, wc, fr, fq); S.done(cur); }
        if (!has_next) break;
#pragma unroll
        for (int a = 0; a < 2; ++a)
#pragma unroll
            for (int b = 0; b < 2; ++b)
#pragma unroll
                for (int m = 0; m < 4; ++m)
#pragma unroll
                    for (int n = 0; n < 2; ++n) acc[a][b][m][n] = (f32x4){0.f, 0.f, 0.f, 0.f};
        cur = nxt; cA = nA; cB = nB; ++ui;
        if constexpr (ALIGN_EPI) { if (wr == 1) PG8_BAR; }
    }
    PG8_WAIT_V(0);
    if constexpr (!ALIGN_EPI) { if (wr == 0) PG8_BAR; }
    PG8_BAR;
    if constexpr (Epi::AFTER_DRAIN) { E.fused(acc, cur, wr, wc, fr, fq, lds, wid, lane); S.done(cur); }
#undef PG8_SA
#undef PG8_SB
#undef PG8_STAGE
#undef PG8_LDA
#undef PG8_LDB
#undef PG8_MMA
#undef PG8_WAIT_V
#undef PG8_WAIT_L
#undef PG8_BAR
#undef PG8_SCHED
}
}
#define GAS __attribute__((address_space(1)))
#define LAS __attribute__((address_space(3)))
typedef unsigned short bf16;
typedef unsigned v4u __attribute__((ext_vector_type(4)));
typedef unsigned v2u __attribute__((ext_vector_type(2)));
typedef float f32x4 __attribute__((ext_vector_type(4)));
typedef float f32x16 __attribute__((ext_vector_type(16)));
typedef short bf16x8 __attribute__((ext_vector_type(8)));
typedef GAS unsigned gu32;
#define RLX_AGENT __ATOMIC_RELAXED, __HIP_MEMORY_SCOPE_AGENT
#define LDS_WAIT() asm volatile("s_waitcnt lgkmcnt(0)" ::: "memory")
#define VM_WAIT() asm volatile("s_waitcnt vmcnt(0)" ::: "memory")
__device__ __forceinline__ unsigned f2bf(float f) { unsigned u = __builtin_bit_cast(unsigned, f); return (u + 0x7fffu + ((u >> 16) & 1u)) >> 16; }
typedef float f32x2_t __attribute__((ext_vector_type(2))); typedef __bf16 bf16x2_t __attribute__((ext_vector_type(2)));
__device__ __forceinline__ unsigned pk2(float lo, float hi) { f32x2_t v = {lo, hi}; bf16x2_t b = __builtin_convertvector(v, bf16x2_t); return __builtin_bit_cast(unsigned, b); }
__device__ __forceinline__ float bf_lo(unsigned w) { return __builtin_bit_cast(float, w << 16); }
__device__ __forceinline__ float bf_hi(unsigned w) { return __builtin_bit_cast(float, w & 0xffff0000u); }

constexpr int D = 1024, PB = 8, PS = 2048, SB = 128, SS = 8, MP = PB * PS, MS = SB * SS, M = MP + MS;
constexpr int TOKW = 512, NMEM = 256, FF = 2816, NPAGES = 16, PAGE = 128, PAST = 2048;
constexpr int MEMROWS = PB * NMEM;
constexpr float EPS = 1e-6f, LOG2E = 1.4426950408889634f;
constexpr int NWAVES = 8;

constexpr int RING_BYTES = 131072;
constexpr int LDS_BYTES = 163840;
constexpr int LCTL_OFF = LDS_BYTES - 1024;
constexpr int EPX_OFF = RING_BYTES;

constexpr size_t MiB = 1u << 20;
constexpr size_t al(size_t x) { return (x + 4095) & ~(size_t)4095; }
constexpr size_t F_CTL = 0, CTL_ZERO_BYTES = 1 * MiB;
constexpr size_t F_WIN0 = F_CTL + CTL_ZERO_BYTES;
constexpr size_t F_W6 = F_WIN0 + al((size_t)D * D * 2);
constexpr size_t F_WOUT = F_W6 + al((size_t)2 * D * D * 2);
constexpr size_t F_WGU = F_WOUT + al((size_t)2 * D * D * 2);
constexpr size_t F_WDOWN = F_WGU + al((size_t)2 * 2 * FF * D * 2);
constexpr size_t F_WMEM = F_WDOWN + al((size_t)2 * D * FF * 2);
constexpr size_t F_WPOOL = F_WMEM + al((size_t)2 * D * D * 2);
constexpr size_t F_WFG = F_WPOOL + al((size_t)4 * 128 * 128 * 2);
constexpr size_t F_XB = F_WFG + al((size_t)8 * D * 4);
constexpr size_t F_MEMB = F_XB + al((size_t)M * D * 2);
constexpr size_t F_ZB = F_MEMB + al((size_t)MEMROWS * D * 2);
constexpr size_t F_Z1B = F_ZB + al((size_t)M * D * 2);
constexpr size_t F_MIXB = F_Z1B + al((size_t)M * D * 2);
constexpr size_t F_HB = F_MIXB + al((size_t)2 * M * D * 2);
constexpr size_t F_HF = F_HB + al((size_t)4 * M * D * 2);
constexpr size_t F_ACTB = F_HF + al((size_t)3 * M * D * 4);
constexpr size_t F_KB = F_ACTB + al((size_t)2 * M * FF * 2);
constexpr size_t F_VB = F_KB + al((size_t)M * TOKW * 2);
constexpr size_t F_MKB = F_VB + al((size_t)M * TOKW * 2);
constexpr size_t F_MVB = F_MKB + al((size_t)2 * MEMROWS * TOKW * 2);
constexpr size_t F_SS0 = F_MVB + al((size_t)2 * MEMROWS * TOKW * 2);
constexpr size_t F_SSM = F_SS0 + al((size_t)M * 4);
constexpr size_t F_SSH = F_SSM + al((size_t)MEMROWS * 4);
constexpr size_t F_END = F_SSH + al((size_t)3 * M * 16 * 4);
constexpr int CW_BAR = 4096;
constexpr int CW_Q = 16384;
constexpr int CW_PANEL = 32768;
constexpr int CW_SDONE = CW_PANEL + 64 * 64;
constexpr int CW_TMO = 8;
static_assert((size_t)(CW_SDONE + 64) * 4 <= CTL_ZERO_BYTES, "control words inside the zeroed region");

struct Args {
    const float* in[28]; float* out; unsigned char* ws; int ph_lo, ph_hi;
};
struct OutPtrs { float *y_p, *y_s, *k_p, *v_p, *lf_p, *mk_p, *mv_p, *ps_p, *k_s, *v_s, *lf_s, *ps_s; };
__host__ __device__ __forceinline__ OutPtrs carve_out(float* o) {
    OutPtrs r; size_t p = 0;
    r.y_p = o + p; p += (size_t)MP * D; r.y_s = o + p; p += (size_t)MS * D;
    r.k_p = o + p; p += (size_t)MP * TOKW; r.v_p = o + p; p += (size_t)MP * TOKW; r.lf_p = o + p; p += (size_t)MP * 8;
    r.mk_p = o + p; p += (size_t)2 * MEMROWS * TOKW; r.mv_p = o + p; p += (size_t)2 * MEMROWS * TOKW; r.ps_p = o + p; p += (size_t)PB * 15 * TOKW;
    r.k_s = o + p; p += (size_t)MS * TOKW; r.v_s = o + p; p += (size_t)MS * TOKW; r.lf_s = o + p; p += (size_t)MS * 8; r.ps_s = o + p; p += (size_t)SB * 15 * TOKW;
    return r;
}

__device__ __forceinline__ float row_rstd(const float* ss, int nparts, int row) {
    float s;
    if (nparts == 1) s = ss[row];
    else { const f32x4* p = (const f32x4*)(ss + (size_t)row * 16); const f32x4 a = p[0], b = p[1], c = p[2], d = p[3];
        s = ((a.x + a.y) + (a.z + a.w)) + ((b.x + b.y) + (b.z + b.w)) + ((c.x + c.y) + (c.z + c.w)) + ((d.x + d.y) + (d.z + d.w)); }
    return 1.0f / sqrtf(s * (1.0f / D) + EPS);
}

constexpr int RT_OFF = RING_BYTES;
template <class Sched> __device__ __forceinline__ void fill_rstd_table(LAS unsigned char* lds, const Sched& S, const float* ss, int nparts, int tid) {
    LAS float* rt = (LAS float*)(lds + RT_OFF); pg8::Unit u;
    for (int i = 0; i < 8 && S.next(i, u); ++i) if (tid < 256) rt[i * 256 + tid] = row_rstd(ss, nparts, u.pm * 256 + tid);
    __syncthreads();
}
namespace epi {
using pg8::Unit; using pg8::f32x4; using pg8::BM; using pg8::HALF;
struct ScaleBf16 {
    static constexpr bool PERM = true, AFTER_DRAIN = false;
    bf16* O; int ldc; const LAS float* rt;
    __device__ __forceinline__ void operator()(const f32x4 (&acc)[2][2][4][2], const Unit& u, int wr, int wc, int fr, int fq) const {
        const int row0 = u.pm * BM + wr * 64 + fr, col0 = u.pn * BM + wc * 32 + 8 * fq; const LAS float* rtu = rt + u.i * 256 + wr * 64 + fr;
#pragma unroll
        for (int ai = 0; ai < 2; ++ai)
#pragma unroll
            for (int m = 0; m < 4; ++m) { const int row = row0 + ai * HALF + m * 16; const float rs = rtu[ai * HALF + m * 16]; bf16* rowp = O + (size_t)row * ldc + col0;
#pragma unroll
                for (int bj = 0; bj < 2; ++bj) { const f32x4 v0 = acc[ai][bj][m][0] * rs, v1 = acc[ai][bj][m][1] * rs;
                    v4u w; w.x = pk2(v0[0], v0[1]); w.y = pk2(v0[2], v0[3]); w.z = pk2(v1[0], v1[1]); w.w = pk2(v1[2], v1[3]);
                    *(v4u*)(rowp + bj * HALF) = w; } }
    }
};
struct MemKV {
    static constexpr bool PERM = true, AFTER_DRAIN = false;
    bf16* MKB; bf16* MVB; float* mv_out; const LAS float* rt; int lbase;
    __device__ __forceinline__ void operator()(const f32x4 (&acc)[2][2][4][2], const Unit& u, int wr, int wc, int fr, int fq) const {
        const int row0 = u.pm * BM + wr * 64 + fr; const int l = lbase + (u.pn >> 2); const bool isv = (u.pn & 2) != 0;
        const int c0 = (u.pn & 1) * BM + wc * 32 + 8 * fq;
        const LAS float* rtu = rt + u.i * 256 + wr * 64 + fr;
#pragma unroll
        for (int ai = 0; ai < 2; ++ai)
#pragma unroll
            for (int m = 0; m < 4; ++m) { const int row = row0 + ai * HALF + m * 16; const float rs = rtu[ai * HALF + m * 16];
                const size_t off = ((size_t)l * MEMROWS + row) * TOKW + c0;
#pragma unroll
                for (int bj = 0; bj < 2; ++bj) { const f32x4 v0 = acc[ai][bj][m][0] * rs, v1 = acc[ai][bj][m][1] * rs;
                    v4u w; w.x = pk2(v0[0], v0[1]); w.y = pk2(v0[2], v0[3]); w.z = pk2(v1[0], v1[1]); w.w = pk2(v1[2], v1[3]);
                    if (isv) { *(v4u*)(MVB + off + bj * HALF) = w; *(f32x4*)(mv_out + off + bj * HALF) = v0; *(f32x4*)(mv_out + off + bj * HALF + 4) = v1; }
                    else *(v4u*)(MKB + off + bj * HALF) = w; } }
    }
};
struct Resid {
    static constexpr bool PERM = true, AFTER_DRAIN = false;
    const bf16* hin; bf16* HB; float* y32; float* ssout;
    __device__ __forceinline__ void operator()(const f32x4 (&acc)[2][2][4][2], const Unit& u, int wr, int wc, int fr, int fq) const {
        const int row0 = u.pm * BM + wr * 64 + fr, col0 = u.pn * BM + wc * 32 + 8 * fq;
#pragma unroll
        for (int ai = 0; ai < 2; ++ai)
#pragma unroll
            for (int m = 0; m < 4; ++m) { const int row = row0 + ai * HALF + m * 16; const size_t off = (size_t)row * D + col0; float s = 0.f;
#pragma unroll
                for (int bj = 0; bj < 2; ++bj) {
                    const v4u r = *(const v4u*)(hin + off + bj * HALF);
                    const f32x4 v0 = acc[ai][bj][m][0] + (f32x4){bf_lo(r.x), bf_hi(r.x), bf_lo(r.y), bf_hi(r.y)}, v1 = acc[ai][bj][m][1] + (f32x4){bf_lo(r.z), bf_hi(r.z), bf_lo(r.w), bf_hi(r.w)};
                    if (y32) { *(f32x4*)(y32 + off + bj * HALF) = v0; *(f32x4*)(y32 + off + bj * HALF + 4) = v1; }
                    if (HB) { v4u w; w.x = pk2(v0[0], v0[1]); w.y = pk2(v0[2], v0[3]); w.z = pk2(v1[0], v1[1]); w.w = pk2(v1[2], v1[3]); *(v4u*)(HB + off + bj * HALF) = w; }
                    s += (v0[0] * v0[0] + v0[1] * v0[1]) + (v0[2] * v0[2] + v0[3] * v0[3]) + (v1[0] * v1[0] + v1[1] * v1[1]) + (v1[2] * v1[2] + v1[3] * v1[3]); }
                if (ssout) { s += __shfl_xor(s, 16); s += __shfl_xor(s, 32); if (fq == 0) ssout[(size_t)row * 16 + u.pn * 4 + wc] = s; } }
    }
};
struct Swiglu {
    static constexpr bool PERM = true, AFTER_DRAIN = false;
    bf16* ACT; const LAS float* rt;
    __device__ __forceinline__ void operator()(const f32x4 (&acc)[2][2][4][2], const Unit& u, int wr, int wc, int fr, int fq) const {
        const int row0 = u.pm * BM + wr * 64 + fr, col0 = u.pn * 128 + wc * 32 + 8 * fq; const LAS float* rtu = rt + u.i * 256 + wr * 64 + fr;
#pragma unroll
        for (int ai = 0; ai < 2; ++ai)
#pragma unroll
            for (int m = 0; m < 4; ++m) { const int row = row0 + ai * HALF + m * 16; const float rs = rtu[ai * HALF + m * 16];
                float a[8];
#pragma unroll
                for (int bj = 0; bj < 2; ++bj) { const f32x4 g = acc[ai][bj][m][0] * rs, uu = acc[ai][bj][m][1] * rs;
#pragma unroll
                    for (int i = 0; i < 4; ++i) a[bj * 4 + i] = g[i] * __builtin_amdgcn_rcpf(1.0f + __builtin_amdgcn_exp2f(-g[i] * LOG2E)) * uu[i]; }
                v4u w; w.x = pk2(a[0], a[1]); w.y = pk2(a[2], a[3]); w.z = pk2(a[4], a[5]); w.w = pk2(a[6], a[7]);
                *(v4u*)(ACT + (size_t)row * FF + col0) = w; }
    }
};
struct KVQ {
    static constexpr bool PERM = true, AFTER_DRAIN = false;
    bf16* KB; bf16* VB; bf16* Z1B; float* k_p; float* k_s; float* v_p; float* v_s; const float* g_fox_k; const LAS float* rt;
    __device__ __forceinline__ void operator()(const f32x4 (&acc)[2][2][4][2], const Unit& u, int wr, int wc, int fr, int fq) const {
        const int row0 = u.pm * BM + wr * 64 + fr; const int kind = u.pn >> 1;
        const LAS float* rtu = rt + u.i * 256 + wr * 64 + fr;
        const int c0 = (u.pn & 1) * BM + wc * 64 + 8 * fq;
        f32x4 gk[2][2];
#pragma unroll
        for (int bj = 0; bj < 2; ++bj)
#pragma unroll
            for (int n = 0; n < 2; ++n) gk[bj][n] = (kind == 0) ? *(const LAS f32x4*)(rt + 2048 + 32 * bj + 8 * fq + 4 * n) : (f32x4){1.f, 1.f, 1.f, 1.f};
#pragma unroll
        for (int ai = 0; ai < 2; ++ai)
#pragma unroll
            for (int m = 0; m < 4; ++m) { const int row = row0 + ai * HALF + m * 16; const float rs = rtu[ai * HALF + m * 16];
                f32x4 v[2][2]; float s = 0.f;
#pragma unroll
                for (int bj = 0; bj < 2; ++bj)
#pragma unroll
                    for (int n = 0; n < 2; ++n) { v[bj][n] = acc[ai][bj][m][n] * rs; s += (v[bj][n][0] * v[bj][n][0] + v[bj][n][1] * v[bj][n][1]) + (v[bj][n][2] * v[bj][n][2] + v[bj][n][3] * v[bj][n][3]); }
                if (kind == 0) { s += __shfl_xor(s, 16); s += __shfl_xor(s, 32); const float rk = 1.0f / sqrtf(s * (1.0f / 64.0f) + EPS);
#pragma unroll
                    for (int bj = 0; bj < 2; ++bj)
#pragma unroll
                        for (int n = 0; n < 2; ++n) v[bj][n] = v[bj][n] * rk * gk[bj][n]; }
                if (kind <= 1) {
                    const bool smp = row >= MP; float* o32 = (kind == 0) ? (smp ? k_s + (size_t)(row - MP) * TOKW : k_p + (size_t)row * TOKW) : (smp ? v_s + (size_t)(row - MP) * TOKW : v_p + (size_t)row * TOKW);
                    bf16* o16 = (kind == 0 ? KB : VB) + (size_t)row * TOKW;
#pragma unroll
                    for (int bj = 0; bj < 2; ++bj) { const int c = c0 + 32 * bj;
                        *(f32x4*)(o32 + c) = v[bj][0]; *(f32x4*)(o32 + c + 4) = v[bj][1];
                        v4u w; w.x = pk2(v[bj][0][0], v[bj][0][1]); w.y = pk2(v[bj][0][2], v[bj][0][3]); w.z = pk2(v[bj][1][0], v[bj][1][1]); w.w = pk2(v[bj][1][2], v[bj][1][3]);
                        *(v4u*)(o16 + c) = w; }
                } else {
                    bf16* o16 = Z1B + (size_t)row * D + (u.pn - 4) * BM + wc * 64 + 8 * fq;
#pragma unroll
                    for (int bj = 0; bj < 2; ++bj) { v4u w; w.x = pk2(v[bj][0][0], v[bj][0][1]); w.y = pk2(v[bj][0][2], v[bj][0][3]); w.z = pk2(v[bj][1][0], v[bj][1][1]); w.w = pk2(v[bj][1][2], v[bj][1][3]);
                        *(v4u*)(o16 + 32 * bj) = w; }
                }
                if (m & 1) asm volatile("" ::: "memory"); }
    }
};
struct Null {
    static constexpr bool PERM = true, AFTER_DRAIN = false;
    float* sink;
    __device__ __forceinline__ void operator()(const f32x4 (&acc)[2][2][4][2], const Unit& u, int wr, int wc, int fr, int fq) const {
        f32x4 s = {0.f, 0.f, 0.f, 0.f};
#pragma unroll
        for (int ai = 0; ai < 2; ++ai)
#pragma unroll
            for (int bj = 0; bj < 2; ++bj)
#pragma unroll
                for (int m = 0; m < 4; ++m) s += acc[ai][bj][m][0] + acc[ai][bj][m][1];
        if (s[0] + s[1] + s[2] + s[3] == 1.2345e33f) sink[0] = 1.f;
    }
};
}
#define XB_TMO      128
#define XB_XCNT(j)  (256  + 64 * (j))
#define XB_XSUB(j)  (1280 + 64 * (j))
#define XB_XGEN(j)  (2304 + 64 * (j))
#define XB_TOP      3328
#define XB_TOPGEN   3392
#define XCD_BAR_WORDS 3456
#define XB_SPIN_CAP (1u << 18)

__device__ __forceinline__ unsigned xb_ld(unsigned* p)              { return __hip_atomic_load(p, __ATOMIC_RELAXED, __HIP_MEMORY_SCOPE_AGENT); }
__device__ __forceinline__ unsigned xb_add(unsigned* p, unsigned v) { return __hip_atomic_fetch_add(p, v, __ATOMIC_RELAXED, __HIP_MEMORY_SCOPE_AGENT); }
__device__ __forceinline__ unsigned xb_xcc_id() { return (unsigned)__builtin_amdgcn_s_getreg((3 << 11) | 20) & 0xFu; }
#define XB_SPIN(cond, bar) do { unsigned _sp = 0; while (cond) { __builtin_amdgcn_s_sleep(1); \
    if ((++_sp & 255u) == 0u) { if (xb_ld(&(bar)[XB_TMO])) break; if (_sp > XB_SPIN_CAP) { atomicAdd(&(bar)[XB_TMO], 1u); break; } } } } while (0)

struct XcdBarrier {
    unsigned* bar; unsigned x;
    volatile LAS unsigned* st;
};

__device__ __forceinline__ XcdBarrier xcd_barrier_post(unsigned* bar, volatile LAS unsigned* st) {
    XcdBarrier b; b.bar = bar; b.x = xb_xcc_id(); b.st = st;
    if (threadIdx.x == 0) (void)xb_add(&bar[XB_XCNT(b.x)], 1u);
    return b;
}
__device__ __forceinline__ void xcd_barrier_complete(unsigned* bar, unsigned x, unsigned& nloc, unsigned& nx) {
    const unsigned G = gridDim.x * gridDim.y * gridDim.z;
    unsigned sum, cnt, mine, sp = 0u;
    for (;;) {
        sum = 0u; cnt = 0u; mine = 0u;
#pragma unroll
        for (unsigned j = 0; j < 16; ++j) { const unsigned c = xb_ld(&bar[XB_XCNT(j)]); sum += c; cnt += (c > 0u) ? 1u : 0u; mine = (j == x) ? c : mine; }
        if (sum == G) break;
        __builtin_amdgcn_s_sleep(1);
        if ((++sp & 255u) == 0u) { if (xb_ld(&bar[XB_TMO])) break; if (sp > XB_SPIN_CAP) { atomicAdd(&bar[XB_TMO], 1u); break; } }
    }
    nloc = mine > 0u ? mine : 1u; nx = cnt > 0u ? cnt : 1u;
}

__device__ __forceinline__ void xcd_barrier(const XcdBarrier& b) {
    asm volatile("s_waitcnt vmcnt(0)" ::: "memory");
    __syncthreads();
    if (threadIdx.x == 0) {
        unsigned* bar = b.bar;
        __builtin_amdgcn_s_waitcnt(0);
        unsigned nloc = b.st[0], nx = b.st[1];
        if (nloc == 0u) { xcd_barrier_complete(bar, b.x, nloc, nx); b.st[0] = nloc; b.st[1] = nx; }
        const unsigned old = xb_add(&bar[XB_XSUB(b.x)], 1u);
        const unsigned gen = old / nloc;
        if (old + 1u == (gen + 1u) * nloc) {
            __builtin_amdgcn_fence(__ATOMIC_RELEASE, "agent");
            asm volatile("s_waitcnt vmcnt(0)" ::: "memory");
            const unsigned og = xb_add(&bar[XB_TOP], 1u);
            const unsigned tg = og / nx;
            if (og + 1u == (tg + 1u) * nx) xb_add(&bar[XB_TOPGEN], 1u);
            else XB_SPIN(xb_ld(&bar[XB_TOPGEN]) == tg, bar);
            __builtin_amdgcn_fence(__ATOMIC_ACQUIRE, "agent");
            xb_add(&bar[XB_XGEN(b.x)], 1u);
            asm volatile("s_waitcnt vmcnt(0)" ::: "memory");
        } else {
            XB_SPIN(xb_ld(&bar[XB_XGEN(b.x)]) == gen, bar);
            __builtin_amdgcn_fence(__ATOMIC_ACQUIRE, "agent");
            asm volatile("s_waitcnt vmcnt(0)" ::: "memory");
        }
    }
    __syncthreads();
}
struct Frame {
    LAS unsigned char* lds;
    volatile LAS unsigned* MISC;
    gu32* ctl;
    int tid, lane, wave, G;
    unsigned char* ws;
    const float* in[28];
    OutPtrs O;
};
__device__ __forceinline__ float wave_sum(float v) {
#pragma unroll
    for (int o = 1; o < 64; o <<= 1) v += __shfl_xor(v, o);
    return v;
}
struct QState { unsigned nxt; int par; };
__device__ __forceinline__ unsigned q_take(Frame& F, int q) { return __hip_atomic_fetch_add((unsigned*)(F.ctl + CW_Q + 64 * q), 1u, __ATOMIC_RELAXED, __HIP_MEMORY_SCOPE_AGENT); }
__device__ __forceinline__ int q_first(Frame& F, int q, QState& st) {
    __syncthreads();
    if (F.tid == 0) F.MISC[0] = blockIdx.x;
    __syncthreads();
    st.par = 1; st.nxt = 0u; return (int)F.MISC[0];
}
__device__ __forceinline__ void q_prefetch(Frame& F, int q, QState& st) { if (F.tid == 0) st.nxt = q_take(F, q) + (unsigned)F.G; }
__device__ __forceinline__ int q_advance(Frame& F, QState& st) {
    if (F.tid == 0) F.MISC[st.par] = st.nxt;
    __syncthreads();
    const int u = (int)F.MISC[st.par]; st.par ^= 1; return u;
}

enum { MAP_ID = 0, MAP_SWIGLU = 1, MAP_HEAD64 = 2 };
template <int MAP> __device__ __forceinline__ int src_col(int p) {
    if (MAP == MAP_SWIGLU) { const int pn = p >> 8, bj = (p >> 7) & 1, wc = (p >> 5) & 3, fq = (p >> 3) & 3, n = (p >> 2) & 1, i = p & 3; return (n ? FF : 0) + 128 * pn + 32 * wc + 8 * fq + 4 * bj + i; }
    if (MAP == MAP_HEAD64) { const int pn = p >> 8, bj = (p >> 7) & 1, wc = (p >> 5) & 3; return 256 * pn + 64 * wc + 32 * bj + (p & 31); }
    return p;
}
template <int MAP> __device__ __forceinline__ void p0_transpose_item(const float* W, int ldw, int K, int Nphys, int col_off, const float* gain, const float* cscale, bf16* WT, int row_off, LAS float* scr, int item, int lane) {
    const int nblk = Nphys / 32, kb = item / nblk, nb = item % nblk, k0 = 64 * kb, n0 = 32 * nb;
    const int sc = src_col<MAP>(n0 + (lane & 31)); const float cs = cscale ? cscale[sc] : 1.0f;
    float wv[32];
#pragma unroll
    for (int i = 0; i < 32; ++i) wv[i] = __builtin_nontemporal_load(W + (size_t)(k0 + 2 * i + (lane >> 5)) * ldw + col_off + sc);
#pragma unroll
    for (int i = 0; i < 32; ++i) { const int kk = 2 * i + (lane >> 5); const float g = gain ? gain[k0 + kk] : 1.0f; scr[kk * 33 + (lane & 31)] = wv[i] * g * cs; }
    LDS_WAIT(); asm volatile("" ::: "memory");
    const int c = lane & 7;
#pragma unroll
    for (int j = 0; j < 4; ++j) { const int n = (lane >> 3) + 8 * j; const LAS float* s = scr + (8 * c) * 33 + n;
        v4u o; o.x = pk2(s[0 * 33], s[1 * 33]); o.y = pk2(s[2 * 33], s[3 * 33]); o.z = pk2(s[4 * 33], s[5 * 33]); o.w = pk2(s[6 * 33], s[7 * 33]);
        *(GAS v4u*)(WT + (size_t)(row_off + n0 + n) * K + k0 + 8 * c) = o; }
    LDS_WAIT(); asm volatile("" ::: "memory");
}
template <int NR> __device__ __forceinline__ void rows_to_bf16(Frame& F, const float* src, size_t rstride, bf16* dst, float* ss) {
    f32x4 v[NR][4];
#pragma unroll
    for (int r = 0; r < NR; ++r)
#pragma unroll
        for (int j = 0; j < 4; ++j) v[r][j] = __builtin_nontemporal_load((const f32x4*)(src + r * rstride) + F.lane + 64 * j);
#pragma unroll
    for (int r = 0; r < NR; ++r) { float s = 0.f;
#pragma unroll
        for (int j = 0; j < 4; ++j) s += (v[r][j].x * v[r][j].x + v[r][j].y * v[r][j].y) + (v[r][j].z * v[r][j].z + v[r][j].w * v[r][j].w);
        s = wave_sum(s);
        GAS unsigned long long* o8 = (GAS unsigned long long*)(dst + r * rstride) + F.lane;
#pragma unroll
        for (int j = 0; j < 4; ++j) o8[64 * j] = (unsigned long long)pk2(v[r][j].x, v[r][j].y) | ((unsigned long long)pk2(v[r][j].z, v[r][j].w) << 32);
        if (F.lane == 0) ss[r] = s; }
}
__device__ __forceinline__ void p0_prologue(Frame& F) {
    LAS float* scr = (LAS float*)(F.lds + F.wave * 16384);
    const int gw = blockIdx.x * NWAVES + F.wave, NGW = F.G * NWAVES;
    const float* g_mix = F.in[10]; const float* w_in = F.in[11]; const float* w_out = F.in[12]; const float* g_ffn = F.in[13]; const float* w_gu = F.in[14]; const float* w_down = F.in[15];
    const float* g_mem = F.in[16]; const float* w_mkv = F.in[17]; const float* w_pool = F.in[20]; const float* pscale = F.in[21]; const float* g_kv = F.in[22]; const float* w_kv = F.in[23]; const float* w_fg = F.in[25];
    bf16* WIN0 = (bf16*)(F.ws + F_WIN0); bf16* W6 = (bf16*)(F.ws + F_W6); bf16* WOUT = (bf16*)(F.ws + F_WOUT); bf16* WGU = (bf16*)(F.ws + F_WGU); bf16* WDOWN = (bf16*)(F.ws + F_WDOWN);
    bf16* WMEM = (bf16*)(F.ws + F_WMEM); bf16* WPOOL = (bf16*)(F.ws + F_WPOOL);
    constexpr int I_SQ = (D / 64) * (D / 32);
    constexpr int I_GU = (D / 64) * (2 * FF / 32), I_DN = (FF / 64) * (D / 32), I_PL = (128 / 64) * (128 / 32);
    constexpr int NITEMS = I_SQ   + 2 * I_SQ   + 2 * I_SQ   + 2 * I_GU + 2 * I_DN + 2 * I_SQ   + 4 * I_PL;
    for (int it = gw; it < NITEMS; it += NGW) {
        int r = it;
        if (r < I_SQ) { p0_transpose_item<MAP_ID>(w_in, D, D, D, 0, g_mix, nullptr, WIN0, 0, scr, r, F.lane); continue; } r -= I_SQ;
        if (r < I_SQ) { p0_transpose_item<MAP_HEAD64>(w_kv, D, D, D, 0, g_kv, nullptr, W6, 0, scr, r, F.lane); continue; } r -= I_SQ;
        if (r < I_SQ) { p0_transpose_item<MAP_HEAD64>(w_in + (size_t)D * D, D, D, D, 0, g_mix + D, nullptr, W6, D, scr, r, F.lane); continue; } r -= I_SQ;
        if (r < 2 * I_SQ) { const int l = r / I_SQ; p0_transpose_item<MAP_ID>(w_out + (size_t)l * D * D, D, D, D, 0, nullptr, nullptr, WOUT + (size_t)l * D * D, 0, scr, r % I_SQ, F.lane); continue; } r -= 2 * I_SQ;
        if (r < 2 * I_GU) { const int l = r / I_GU; p0_transpose_item<MAP_SWIGLU>(w_gu + (size_t)l * D * 2 * FF, 2 * FF, D, 2 * FF, 0, g_ffn + l * D, nullptr, WGU + (size_t)l * 2 * FF * D, 0, scr, r % I_GU, F.lane); continue; } r -= 2 * I_GU;
        if (r < 2 * I_DN) { const int l = r / I_DN; p0_transpose_item<MAP_ID>(w_down + (size_t)l * FF * D, D, FF, D, 0, nullptr, nullptr, WDOWN + (size_t)l * D * FF, 0, scr, r % I_DN, F.lane); continue; } r -= 2 * I_DN;
        if (r < 2 * I_SQ) { const int l = r / I_SQ; p0_transpose_item<MAP_ID>(w_mkv + (size_t)l * D * D, D, D, D, 0, g_mem + l * D, nullptr, WMEM, l * D, scr, r % I_SQ, F.lane); continue; } r -= 2 * I_SQ;
        { const int g = r / I_PL; p0_transpose_item<MAP_ID>(w_pool + (size_t)g * 128 * 128, 128, 128, 128, 0, nullptr, pscale + g * 128, WPOOL + (size_t)g * 128 * 128, 0, scr, r % I_PL, F.lane); }
    }
    { float* WFG = (float*)(F.ws + F_WFG); for (int i = blockIdx.x * 512 + F.tid; i < 8 * D; i += F.G * 512) { const int h = i >> 10, k = i & 1023; WFG[i] = w_fg[k * 8 + h] * g_kv[k]; } }
    bf16* XB = (bf16*)(F.ws + F_XB); float* SS0 = (float*)(F.ws + F_SS0);
    for (int m = 4 * gw; m < M; m += 4 * NGW) { const float* src = (m < MP) ? F.in[0] + (size_t)m * D : F.in[1] + (size_t)(m - MP) * D; rows_to_bf16<4>(F, src, D, XB + (size_t)m * D, SS0 + m); }
    bf16* MEMB = (bf16*)(F.ws + F_MEMB); float* SSM = (float*)(F.ws + F_SSM);
    for (int m = 4 * gw; m < MEMROWS; m += 4 * NGW) rows_to_bf16<4>(F, F.in[9] + (size_t)m * D, D, MEMB + (size_t)m * D, SSM + m);
}

constexpr int KPB = 1040;
template <int HD> __device__ __forceinline__ int v_off(int kv, int c16) { return HD == 64 ? kv * 128 + ((c16 ^ (4 * ((kv >> 1) & 1))) << 4) : kv * 256 + ((c16 ^ (4 * (kv & 3))) << 4); }
typedef short s16x4_t __attribute__((ext_vector_type(4)));
__device__ __forceinline__ s16x4_t tr_read(const LAS unsigned char* p) { return __builtin_amdgcn_ds_read_tr16_b64_v4i16((LAS s16x4_t*)p); }
constexpr float NEG_BIG = -1.0e30f;
template <int HD> struct AttnSt { float m, l; f32x16 o[HD / 32]; };
template <int HD> __device__ __forceinline__ void attn_init(AttnSt<HD>& S) {
    S.m = NEG_BIG; S.l = 0.f;
#pragma unroll
    for (int i = 0; i < HD / 32; ++i)
#pragma unroll
        for (int r = 0; r < 16; ++r) S.o[i][r] = 0.f;
}
template <int HD, bool BIAS, bool MASK, bool NOMAX = false>
__device__ __forceinline__ void attn_tile(AttnSt<HD>& S, const LAS unsigned char* Kt, const LAS unsigned char* Vt, const bf16x8 (&qf)[HD / 16], const LAS float* nb, int kpos0, int qpos, int nvalid, int lane) {
    const int r32 = lane & 31, hi = lane >> 5;
    f32x16 p[2];
    bf16x8 ka[2][HD / 16];
#pragma unroll
    for (int kvb = 0; kvb < 2; ++kvb)
#pragma unroll
        for (int d0 = 0; d0 < HD / 16; ++d0) ka[kvb][d0] = *(const LAS bf16x8*)(Kt + (d0 * 2 + hi) * KPB + (32 * kvb + r32) * 16);
    __builtin_amdgcn_sched_barrier(0);
#pragma unroll
    for (int kvb = 0; kvb < 2; ++kvb) {
#pragma unroll
        for (int r = 0; r < 16; ++r) p[kvb][r] = NOMAX ? -S.m : 0.f;
#pragma unroll
        for (int d0 = 0; d0 < HD / 16; ++d0) p[kvb] = __builtin_amdgcn_mfma_f32_32x32x16_bf16(ka[kvb][d0], qf[d0], p[kvb], 0, 0, 0);
    }
    s16x4_t va[HD / 32][2][2][2];
    {   const int g = lane >> 4, q4 = (lane >> 2) & 3, p4 = lane & 3;
#pragma unroll
        for (int i = 0; i < HD / 32; ++i) { const int dcol = 32 * i + 16 * (g & 1) + 4 * p4, c16 = dcol >> 3, hb = ((dcol >> 2) & 1) * 8;
#pragma unroll
            for (int kvb = 0; kvb < 2; ++kvb)
#pragma unroll
                for (int s = 0; s < 2; ++s) { const int kvA = 32 * kvb + 16 * s + 4 * hi + q4;
                    va[i][kvb][s][0] = tr_read(Vt + v_off<HD>(kvA, c16) + hb); va[i][kvb][s][1] = tr_read(Vt + v_off<HD>(kvA + 8, c16) + hb); } }
    }
    __builtin_amdgcn_sched_barrier(0);
    if (BIAS) {
#pragma unroll
        for (int kvb = 0; kvb < 2; ++kvb)
#pragma unroll
            for (int g = 0; g < 4; ++g) { const f32x4 b = *(const LAS f32x4*)(nb + 32 * kvb + 8 * g + 4 * hi);
                p[kvb][4 * g + 0] += b.x; p[kvb][4 * g + 1] += b.y; p[kvb][4 * g + 2] += b.z; p[kvb][4 * g + 3] += b.w; }
    }
    if (MASK) {
#pragma unroll
        for (int kvb = 0; kvb < 2; ++kvb)
#pragma unroll
            for (int r = 0; r < 16; ++r) { const int kv = 32 * kvb + (r & 3) + 8 * (r >> 2) + 4 * hi; if (kv >= nvalid || kpos0 + kv > qpos) p[kvb][r] = NEG_BIG; }
    }
    if (NOMAX) {
        float rs = 0.f;
#pragma unroll
        for (int kvb = 0; kvb < 2; ++kvb)
#pragma unroll
            for (int r = 0; r < 16; ++r) { p[kvb][r] = __builtin_amdgcn_exp2f(p[kvb][r]); rs += p[kvb][r]; }
        S.l += rs;
    } else {
    float mx = p[0][0];
#pragma unroll
    for (int r = 1; r < 16; ++r) mx = fmaxf(mx, p[0][r]);
#pragma unroll
    for (int r = 0; r < 16; ++r) mx = fmaxf(mx, p[1][r]);
    mx = fmaxf(mx, __shfl_xor(mx, 32));
    const float mn = fmaxf(S.m, mx), alpha = __builtin_amdgcn_exp2f(S.m - mn);
    S.m = mn;
    float rs = 0.f;
#pragma unroll
    for (int kvb = 0; kvb < 2; ++kvb)
#pragma unroll
        for (int r = 0; r < 16; ++r) { p[kvb][r] = __builtin_amdgcn_exp2f(p[kvb][r] - mn); rs += p[kvb][r]; }
    S.l = S.l * alpha + rs;
#pragma unroll
    for (int i = 0; i < HD / 32; ++i)
#pragma unroll
        for (int r = 0; r < 16; ++r) S.o[i][r] *= alpha;
    }
    bf16x8 pf[2][2];
#pragma unroll
    for (int kvb = 0; kvb < 2; ++kvb)
#pragma unroll
        for (int s = 0; s < 2; ++s) { v4u w; w.x = pk2(p[kvb][8 * s + 0], p[kvb][8 * s + 1]); w.y = pk2(p[kvb][8 * s + 2], p[kvb][8 * s + 3]); w.z = pk2(p[kvb][8 * s + 4], p[kvb][8 * s + 5]); w.w = pk2(p[kvb][8 * s + 6], p[kvb][8 * s + 7]);
            pf[kvb][s] = __builtin_bit_cast(bf16x8, w); }
#pragma unroll
    for (int i = 0; i < HD / 32; ++i)
#pragma unroll
        for (int kvb = 0; kvb < 2; ++kvb)
#pragma unroll
            for (int s = 0; s < 2; ++s) { const s16x4_t lo = va[i][kvb][s][0], hi4 = va[i][kvb][s][1];
                const bf16x8 a = {lo[0], lo[1], lo[2], lo[3], hi4[0], hi4[1], hi4[2], hi4[3]};
                S.o[i] = __builtin_amdgcn_mfma_f32_32x32x16_bf16(a, pf[kvb][s], S.o[i], 0, 0, 0); }
}

struct AttnSt16 { float m, l; f32x4 o[4]; };
__device__ __forceinline__ void attn_init16(AttnSt16& S, float mref) { S.m = mref; S.l = 0.f;
#pragma unroll
    for (int i = 0; i < 4; ++i) S.o[i] = (f32x4){0.f, 0.f, 0.f, 0.f}; }
template <bool MASK>
__device__ __forceinline__ void attn_tile16(AttnSt16& S, const LAS unsigned char* Kt, const LAS unsigned char* Vt, const LAS unsigned char* qp, const LAS float* nb, int kpos0, int qpos, int nvalid, int lane) {
    const int q = lane & 15, kq = lane >> 4;
    bf16x8 qf[2];
#pragma unroll
    for (int ks = 0; ks < 2; ++ks) { qf[ks] = *(const LAS bf16x8*)(qp + ((4 * ks + kq) * 8 + (q & 7)) * 16); if (q >= 8) qf[ks] = (bf16x8){0, 0, 0, 0, 0, 0, 0, 0}; }
    f32x4 p[4]; float rs = 0.f;
#pragma unroll
    for (int blk = 0; blk < 4; ++blk) {
        p[blk] = (f32x4){-S.m, -S.m, -S.m, -S.m};
#pragma unroll
        for (int ks = 0; ks < 2; ++ks) { const bf16x8 a = *(const LAS bf16x8*)(Kt + (4 * ks + kq) * KPB + (16 * blk + q) * 16); p[blk] = __builtin_amdgcn_mfma_f32_16x16x32_bf16(a, qf[ks], p[blk], 0, 0, 0); }
        const f32x4 bb = *(const LAS f32x4*)(nb + 16 * blk + 4 * kq);
        p[blk] += bb;
        if (MASK) {
#pragma unroll
            for (int r = 0; r < 4; ++r) { const int kv = 16 * blk + 4 * kq + r; if (kv >= nvalid || kpos0 + kv > qpos) p[blk][r] = NEG_BIG; } }
#pragma unroll
        for (int r = 0; r < 4; ++r) { p[blk][r] = __builtin_amdgcn_exp2f(p[blk][r]); rs += p[blk][r]; }
    }
    S.l += rs;
    const int q4 = (lane >> 2) & 3, p4 = lane & 3;
#pragma unroll
    for (int s = 0; s < 2; ++s) {
        v4u w; w.x = pk2(p[2 * s][0], p[2 * s][1]); w.y = pk2(p[2 * s][2], p[2 * s][3]); w.z = pk2(p[2 * s + 1][0], p[2 * s + 1][1]); w.w = pk2(p[2 * s + 1][2], p[2 * s + 1][3]);
        const bf16x8 pf = __builtin_bit_cast(bf16x8, w);
        const int kvA = 32 * s + 4 * kq + q4;
#pragma unroll
        for (int dblk = 0; dblk < 4; ++dblk) { const int c16 = 2 * dblk + (p4 >> 1), hb = (p4 & 1) * 8;
            const s16x4_t lo = tr_read(Vt + v_off<64>(kvA, c16) + hb), hi4 = tr_read(Vt + v_off<64>(kvA + 16, c16) + hb);
            const bf16x8 a = {lo[0], lo[1], lo[2], lo[3], hi4[0], hi4[1], hi4[2], hi4[3]};
            S.o[dblk] = __builtin_amdgcn_mfma_f32_16x16x32_bf16(a, pf, S.o[dblk], 0, 0, 0); }
    }
}
template <int HD> __device__ __forceinline__ void load_q(bf16x8 (&qf)[HD / 16], const bf16* zrow  , const float* g, float qscale, bool valid, int lane) {
    const int hi = lane >> 5;
    v4u raw[HD / 16]; float s = 0.f;
#pragma unroll
    for (int d0 = 0; d0 < HD / 16; ++d0) { raw[d0] = valid ? *(const v4u*)(zrow + 16 * d0 + 8 * hi) : (v4u){0u, 0u, 0u, 0u};
        const float a0 = bf_lo(raw[d0].x), a1 = bf_hi(raw[d0].x), a2 = bf_lo(raw[d0].y), a3 = bf_hi(raw[d0].y), a4 = bf_lo(raw[d0].z), a5 = bf_hi(raw[d0].z), a6 = bf_lo(raw[d0].w), a7 = bf_hi(raw[d0].w);
        s += (a0 * a0 + a1 * a1) + (a2 * a2 + a3 * a3) + (a4 * a4 + a5 * a5) + (a6 * a6 + a7 * a7); }
    s += __shfl_xor(s, 32);
    const float r = qscale / sqrtf(s * (1.0f / HD) + EPS);
#pragma unroll
    for (int d0 = 0; d0 < HD / 16; ++d0) { const f32x4 g0 = *(const f32x4*)(g + 16 * d0 + 8 * hi), g1 = *(const f32x4*)(g + 16 * d0 + 8 * hi + 4);
        v4u w; w.x = pk2(bf_lo(raw[d0].x) * r * g0.x, bf_hi(raw[d0].x) * r * g0.y); w.y = pk2(bf_lo(raw[d0].y) * r * g0.z, bf_hi(raw[d0].y) * r * g0.w);
        w.z = pk2(bf_lo(raw[d0].z) * r * g1.x, bf_hi(raw[d0].z) * r * g1.y); w.w = pk2(bf_lo(raw[d0].w) * r * g1.z, bf_hi(raw[d0].w) * r * g1.w);
        qf[d0] = __builtin_bit_cast(bf16x8, w); }
}
template <int HD, bool WT = false> __device__ __forceinline__ void store_o(const AttnSt<HD>& S, bf16* orow, int lane) {
    const int hi = lane >> 5; const float lt = S.l + __shfl_xor(S.l, 32); const float inv = 1.0f / lt;
#pragma unroll
    for (int i = 0; i < HD / 32; ++i)
#pragma unroll
        for (int j = 0; j < 2; ++j) {
            const unsigned x0 = pk2(S.o[i][8 * j + 0] * inv, S.o[i][8 * j + 1] * inv), x1 = pk2(S.o[i][8 * j + 2] * inv, S.o[i][8 * j + 3] * inv);
            const unsigned y0 = pk2(S.o[i][8 * j + 4] * inv, S.o[i][8 * j + 5] * inv), y1 = pk2(S.o[i][8 * j + 6] * inv, S.o[i][8 * j + 7] * inv);
            const auto r0 = __builtin_amdgcn_permlane32_swap(x0, y0, false, false), r1 = __builtin_amdgcn_permlane32_swap(x1, y1, false, false);
            v4u w; w.x = r0[0]; w.y = r1[0]; w.z = r0[1]; w.w = r1[1];
            *(v4u*)(orow + 32 * i + 16 * j + 8 * hi) = w; }
}
__device__ __forceinline__ void arrive(Frame& F, int cw) {
    asm volatile("s_waitcnt vmcnt(0)" ::: "memory");
    __syncthreads();
    if (F.tid == 0) (void)__hip_atomic_fetch_add((unsigned*)(F.ctl + cw), 1u, __ATOMIC_RELAXED, __HIP_MEMORY_SCOPE_AGENT);
}
__device__ __forceinline__ void wait_count(Frame& F, int cw, unsigned want) {
    if (F.tid == 0) {
        unsigned sp = 0;
        while (__hip_atomic_load((unsigned*)(F.ctl + cw), __ATOMIC_RELAXED, __HIP_MEMORY_SCOPE_AGENT) < want) {
            __builtin_amdgcn_s_sleep(2);
            if (++sp > (1u << 22)) { __hip_atomic_store((unsigned*)(F.ctl + CW_TMO), 1u, __ATOMIC_RELAXED, __HIP_MEMORY_SCOPE_AGENT); break; }
        }
        __builtin_amdgcn_fence(__ATOMIC_ACQUIRE, "agent");
        asm volatile("s_waitcnt vmcnt(0)" ::: "memory");
    }
    __syncthreads();
}
namespace sg {
constexpr int PITCH = 144, TILEB = 64 * PITCH, RED_OFF = 6 * TILEB;
struct MapId { __device__ __forceinline__ int operator()(int L) const { return L; } };
struct MapHead64 { __device__ __forceinline__ int operator()(int L) const { return (L & ~255) | (((L >> 5) & 1) << 7) | (((L >> 6) & 3) << 5) | (L & 31); } };
template <int RB, class BMap, class Epi>
__device__ __forceinline__ void small_gemm(Frame& F, const bf16* A, const bf16* Bt, int K, int tm, int tn, int row_base, const BMap& bm, const Epi& E) {
    int tid_ = F.tid; asm volatile("" : "+v"(tid_));
    const int lr = tid_ >> 3, lc = tid_ & 7, wm = F.wave & 3, kh = F.wave >> 2, r = tid_ & 15, kq = (tid_ & 63) >> 4;
    const bf16* ap = A + (size_t)(tm * 64 * RB + lr) * K + lc * 8; const bf16* bp = Bt + (size_t)bm(tn * 64 + lr) * K + lc * 8;
    constexpr int ATILE = RB * TILEB;
    LAS unsigned char* sA = F.lds; LAS unsigned char* sB = F.lds + 2 * ATILE;
    const int woff = lr * PITCH + lc * 16, aoff = (16 * wm + r) * PITCH + (32 * kh + 8 * kq) * 2, boff = r * PITCH + (32 * kh + 8 * kq) * 2;
    f32x4 acc[RB][4];
#pragma unroll
    for (int rb = 0; rb < RB; ++rb)
#pragma unroll
        for (int cb = 0; cb < 4; ++cb) acc[rb][cb] = (f32x4){0.f, 0.f, 0.f, 0.f};
    const int nk = K / 64;
    constexpr int PF = 8;
    v4u ra[PF][RB], rb_[PF];
#pragma unroll
    for (int j = 0; j < PF; ++j) if (j < nk) {
#pragma unroll
        for (int rb = 0; rb < RB; ++rb) ra[j][rb] = *(const v4u*)(ap + (size_t)rb * 64 * K + j * 64);
        rb_[j] = *(const v4u*)(bp + j * 64); }
#pragma unroll
    for (int rb = 0; rb < RB; ++rb) *(LAS v4u*)(sA + rb * TILEB + woff) = ra[0][rb];
    *(LAS v4u*)(sB + woff) = rb_[0];
    __syncthreads();
#pragma unroll 1
    for (int s0 = 0; s0 < nk; s0 += PF) {
#pragma unroll
        for (int j = 0; j < PF; ++j) { const int s = s0 + j;
            if (s < nk) {
                const int bo = (s & 1) * TILEB, ao = (s & 1) * ATILE;
                bf16x8 af[RB];
#pragma unroll
                for (int rb = 0; rb < RB; ++rb) af[rb] = *(const LAS bf16x8*)(sA + ao + rb * TILEB + aoff);
#pragma unroll
                for (int cb = 0; cb < 4; ++cb) { const bf16x8 bfr = *(const LAS bf16x8*)(sB + bo + boff + cb * 16 * PITCH);
#pragma unroll
                    for (int rb = 0; rb < RB; ++rb) acc[rb][cb] = __builtin_amdgcn_mfma_f32_16x16x32_bf16(bfr, af[rb], acc[rb][cb], 0, 0, 0); }
                if (s + 1 < nk) { const int no = ((s + 1) & 1) * TILEB, na = ((s + 1) & 1) * ATILE;
#pragma unroll
                    for (int rb = 0; rb < RB; ++rb) *(LAS v4u*)(sA + na + rb * TILEB + woff) = ra[(j + 1) % PF][rb];
                    *(LAS v4u*)(sB + no + woff) = rb_[(j + 1) % PF]; }
                if (s + PF < nk) {
#pragma unroll
                    for (int rb = 0; rb < RB; ++rb) ra[j][rb] = *(const v4u*)(ap + (size_t)rb * 64 * K + (size_t)(s + PF) * 64);
                    rb_[j] = *(const v4u*)(bp + (size_t)(s + PF) * 64); }
                __syncthreads();
            }
        }
    }
    LAS f32x4* red = (LAS f32x4*)(F.lds + RED_OFF);
    if (kh == 1) {
#pragma unroll
        for (int rb = 0; rb < RB; ++rb)
#pragma unroll
            for (int cb = 0; cb < 4; ++cb) red[((rb * 4 + wm) * 4 + cb) * 64 + (tid_ & 63)] = acc[rb][cb];
    }
    __syncthreads();
    if (kh == 0) {
#pragma unroll
        for (int rb = 0; rb < RB; ++rb) {
#pragma unroll
            for (int cb = 0; cb < 4; ++cb) acc[rb][cb] += red[((rb * 4 + wm) * 4 + cb) * 64 + (tid_ & 63)];
            E(row_base + tm * 64 * RB + 64 * rb + 16 * wm + r, tn, acc[rb], kq); }
    }
}
template <class BMap, class Epi>
__device__ __forceinline__ void small_gemm(Frame& F, const bf16* A, const bf16* Bt, int K, int tm, int tn, int row_base, const BMap& bm, const Epi& E) { small_gemm<1>(F, A, Bt, K, tm, tn, row_base, bm, E); }
struct EScale {
    bf16* O; int ldc; const float* ss; int nparts;
    __device__ __forceinline__ void operator()(int row, int ct, const f32x4 (&acc)[4], int kq) const {
        const float rs = row_rstd(ss, nparts, row); bf16* o = O + (size_t)row * ldc + 64 * ct + 4 * kq;
#pragma unroll
        for (int cb = 0; cb < 4; ++cb) { const f32x4 v = acc[cb] * rs; v2u w; w.x = pk2(v[0], v[1]); w.y = pk2(v[2], v[3]); *(v2u*)(o + 16 * cb) = w; }
    }
};
struct EMemKV {
    bf16* MKB; bf16* MVB; float* mv_out; const float* ss; int l;
    __device__ __forceinline__ void operator()(int row, int ct, const f32x4 (&acc)[4], int kq) const {
        const float rs = row_rstd(ss, 1, row); const bool isv = ct >= 8; const size_t off = ((size_t)l * MEMROWS + row) * TOKW + 64 * (ct & 7) + 4 * kq;
#pragma unroll
        for (int cb = 0; cb < 4; ++cb) { const f32x4 v = acc[cb] * rs; v2u w; w.x = pk2(v[0], v[1]); w.y = pk2(v[2], v[3]);
            if (isv) { *(v2u*)(MVB + off + 16 * cb) = w; *(f32x4*)(mv_out + off + 16 * cb) = v; } else *(v2u*)(MKB + off + 16 * cb) = w; }
    }
};
struct EResid {
    const bf16* hin; bf16* HB; float* y32; float* ssout;
    __device__ __forceinline__ void operator()(int row, int ct, const f32x4 (&acc)[4], int kq) const {
        const size_t off = (size_t)row * D + 64 * ct + 4 * kq; float s = 0.f;
#pragma unroll
        for (int cb = 0; cb < 4; ++cb) { const v2u r = *(const v2u*)(hin + off + 16 * cb); const f32x4 v = acc[cb] + (f32x4){bf_lo(r.x), bf_hi(r.x), bf_lo(r.y), bf_hi(r.y)};
            if (y32) *(f32x4*)(y32 + off + 16 * cb) = v;
            if (HB) { v2u w; w.x = pk2(v[0], v[1]); w.y = pk2(v[2], v[3]); *(v2u*)(HB + off + 16 * cb) = w; }
            s += (v[0] * v[0] + v[1] * v[1]) + (v[2] * v[2] + v[3] * v[3]); }
        if (ssout) { s += __shfl_xor(s, 16); s += __shfl_xor(s, 32); if (kq == 0) ssout[(size_t)row * 16 + ct] = s; }
    }
};
struct EKVQ {
    bf16* KB; bf16* VB; bf16* Z1B; float* k_s; float* v_s; const float* g_fox_k; const float* ss;
    __device__ __forceinline__ void operator()(int row, int ct, const f32x4 (&acc)[4], int kq) const {
        const float rs = row_rstd(ss, 16, row); f32x4 v[4]; float s = 0.f;
#pragma unroll
        for (int cb = 0; cb < 4; ++cb) { v[cb] = acc[cb] * rs; s += (v[cb][0] * v[cb][0] + v[cb][1] * v[cb][1]) + (v[cb][2] * v[cb][2] + v[cb][3] * v[cb][3]); }
        if (ct < 8) { s += __shfl_xor(s, 16); s += __shfl_xor(s, 32); const float rk = 1.0f / sqrtf(s * (1.0f / 64.0f) + EPS);
#pragma unroll
            for (int cb = 0; cb < 4; ++cb) v[cb] = v[cb] * rk * *(const f32x4*)(g_fox_k + 16 * cb + 4 * kq); }
        if (ct < 16) { float* o32 = (ct < 8 ? k_s : v_s) + (size_t)(row - MP) * TOKW + 64 * (ct & 7) + 4 * kq; bf16* o16 = (ct < 8 ? KB : VB) + (size_t)row * TOKW + 64 * (ct & 7) + 4 * kq;
#pragma unroll
            for (int cb = 0; cb < 4; ++cb) { *(f32x4*)(o32 + 16 * cb) = v[cb]; v2u w; w.x = pk2(v[cb][0], v[cb][1]); w.y = pk2(v[cb][2], v[cb][3]); *(v2u*)(o16 + 16 * cb) = w; } }
        else { bf16* o16 = Z1B + (size_t)row * D + 64 * (ct - 16) + 4 * kq;
#pragma unroll
            for (int cb = 0; cb < 4; ++cb) { v2u w; w.x = pk2(v[cb][0], v[cb][1]); w.y = pk2(v[cb][2], v[cb][3]); *(v2u*)(o16 + 16 * cb) = w; } }
    }
};
}
constexpr float C2MEM = 0.08838834764831845f * LOG2E, C2FOX = 0.125f * LOG2E;
constexpr int KT128 = 16 * KPB  , VT128 = 64 * 256  , KT64 = 8 * KPB  , VT64 = 64 * 128  ;
constexpr int MEM_K_OFF = 0, MEM_V_OFF = 4 * KT128  , MEM_END = MEM_V_OFF + 4 * VT128  ;
static_assert(MEM_END + 4 * 8 * 128 * 4 + 256 <= LCTL_OFF, "memory-attention LDS map");

template <int HD> __device__ __forceinline__ void merge_write(const AttnSt<HD>& S, LAS float* mbuf, int nw, int w, int lane) {
    const int r32 = lane & 31, hi = lane >> 5; const float lt = S.l + __shfl_xor(S.l, 32);
    if (r32 < 8) {
        LAS float* O = mbuf + ((size_t)w * 8 + r32) * HD;
#pragma unroll
        for (int i = 0; i < HD / 32; ++i)
#pragma unroll
            for (int r = 0; r < 16; ++r) O[32 * i + (r & 3) + 8 * (r >> 2) + 4 * hi] = S.o[i][r];
        if (hi == 0) { LAS float* ML = mbuf + (size_t)nw * 8 * HD + (w * 8 + r32) * 2; ML[0] = S.m; ML[1] = lt; }
    }
}
__device__ __forceinline__ void merge_write16(const AttnSt16& S, LAS float* mbuf, int nw, int w, int lane) {
    const int q = lane & 15, kq = lane >> 4; float lt = S.l; lt += __shfl_xor(lt, 16); lt += __shfl_xor(lt, 32);
    if (q < 8) {
        LAS float* O = mbuf + ((size_t)w * 8 + q) * 64;
#pragma unroll
        for (int i = 0; i < 4; ++i) *(LAS f32x4*)(O + 16 * i + 4 * kq) = S.o[i];
        if (kq == 0) { LAS float* ML = mbuf + (size_t)nw * 8 * 64 + (w * 8 + q) * 2; ML[0] = S.m; ML[1] = lt; }
    }
}
template <int HD> __device__ __forceinline__ float merge_read(const LAS float* mbuf, int nw, int q, int d) {
    const LAS float* ML = mbuf + (size_t)nw * 8 * HD; float mx = NEG_BIG;
    for (int w = 0; w < nw; ++w) mx = fmaxf(mx, ML[(w * 8 + q) * 2]);
    float num = 0.f, den = 0.f;
    for (int w = 0; w < nw; ++w) { const float f = __builtin_amdgcn_exp2f(ML[(w * 8 + q) * 2] - mx); num += f * mbuf[((size_t)w * 8 + q) * HD + d]; den += f * ML[(w * 8 + q) * 2 + 1]; }
    return num / den;
}

__device__ __forceinline__ void unit_pm(Frame& F, QState& qs, int qid, int l, int b, int hd, int qb) {
    int tid_ = F.tid, lane_ = F.lane; asm volatile("" : "+v"(tid_), "+v"(lane_));
    const bf16* MKB = (const bf16*)(F.ws + F_MKB); const bf16* MVB = (const bf16*)(F.ws + F_MVB);
    const bf16* Z = (const bf16*)(F.ws + (l == 0 ? F_ZB : F_Z1B)); bf16* MIXB = (bf16*)(F.ws + F_MIXB) + (size_t)l * M * D;
    const float* g_mem_k = F.in[19] + l * 128; const float* g_mem_q = F.in[18] + l * 128;
    {
        const int c = tid_ & 15, r0 = tid_ >> 4; const size_t cbase = ((size_t)l * MEMROWS + b * NMEM) * TOKW + hd * 128 + 8 * c;
        v4u kr[8], vr[8];
#pragma unroll
        for (int p = 0; p < 8; ++p) { kr[p] = *(const v4u*)(MKB + cbase + (size_t)(r0 + 32 * p) * TOKW); vr[p] = *(const v4u*)(MVB + cbase + (size_t)(r0 + 32 * p) * TOKW); }
        const f32x4 g0 = *(const f32x4*)(g_mem_k + 8 * c), g1 = *(const f32x4*)(g_mem_k + 8 * c + 4);
#pragma unroll
        for (int p = 0; p < 8; ++p) { const int kv = r0 + 32 * p;
            const float a0 = bf_lo(kr[p].x), a1 = bf_hi(kr[p].x), a2 = bf_lo(kr[p].y), a3 = bf_hi(kr[p].y), a4 = bf_lo(kr[p].z), a5 = bf_hi(kr[p].z), a6 = bf_lo(kr[p].w), a7 = bf_hi(kr[p].w);
            float s = (a0 * a0 + a1 * a1) + (a2 * a2 + a3 * a3) + (a4 * a4 + a5 * a5) + (a6 * a6 + a7 * a7);
            s += __shfl_xor(s, 1); s += __shfl_xor(s, 2); s += __shfl_xor(s, 4); s += __shfl_xor(s, 8);
            const float r = 1.0f / sqrtf(s * (1.0f / 128.0f) + EPS);
            const f32x4 v0 = {a0 * r * g0.x, a1 * r * g0.y, a2 * r * g0.z, a3 * r * g0.w}, v1 = {a4 * r * g1.x, a5 * r * g1.y, a6 * r * g1.z, a7 * r * g1.w};
            v4u w; w.x = pk2(v0[0], v0[1]); w.y = pk2(v0[2], v0[3]); w.z = pk2(v1[0], v1[1]); w.w = pk2(v1[2], v1[3]);
            *(LAS v4u*)(F.lds + MEM_K_OFF + (kv >> 6) * KT128 + c * KPB + (kv & 63) * 16) = w;
            if (qb == 0) { float* o = F.O.mk_p + cbase + (size_t)kv * TOKW; *(f32x4*)o = v0; *(f32x4*)(o + 4) = v1; }
            *(LAS v4u*)(F.lds + MEM_V_OFF + (kv >> 6) * VT128 + v_off<128>(kv & 63, c)) = vr[p]; }
    }
    __syncthreads();
    const int r32 = lane_ & 31; const size_t row = (size_t)b * PS + qb * 256 + F.wave * 32 + r32;
    bf16x8 qf[8]; load_q<128>(qf, Z + row * D + TOKW + hd * 128, g_mem_q, C2MEM, true, lane_);
    AttnSt<128> S; attn_init<128>(S); S.m = 0.f;
    q_prefetch(F, qid, qs);
#pragma unroll 1
    for (int t = 0; t < 4; ++t) attn_tile<128, false, false, true>(S, F.lds + MEM_K_OFF + t * KT128, F.lds + MEM_V_OFF + t * VT128, qf, nullptr, 0, 0, 64, lane_);
    store_o<128>(S, MIXB + row * D + TOKW + hd * 128, lane_);
}

__device__ __forceinline__ void unit_sm(Frame& F, QState& qs, int qid, int l, int b, int hd) {
    int tid_ = F.tid, lane_ = F.lane; asm volatile("" : "+v"(tid_), "+v"(lane_));
    const float* CK = F.in[2] + ((size_t)(l * SB + b) * NMEM) * TOKW + hd * 128; const float* CV = F.in[3] + ((size_t)(l * SB + b) * NMEM) * TOKW + hd * 128;
    const bf16* Z = (const bf16*)(F.ws + (l == 0 ? F_ZB : F_Z1B)); bf16* MIXB = (bf16*)(F.ws + F_MIXB) + (size_t)l * M * D; const float* g_mem_q = F.in[18] + l * 128;
    {
        const int rsub = lane_ >> 5, c4 = lane_ & 31;
        f32x4 kx[16], vx[16];
#pragma unroll
        for (int j = 0; j < 16; ++j) { const int kv = F.wave * 32 + 2 * j + rsub; kx[j] = __builtin_nontemporal_load((const f32x4*)(CK + (size_t)kv * TOKW + 4 * c4)); vx[j] = __builtin_nontemporal_load((const f32x4*)(CV + (size_t)kv * TOKW + 4 * c4)); }
#pragma unroll
        for (int j = 0; j < 16; ++j) { const int kv = F.wave * 32 + 2 * j + rsub, t = kv >> 6, kl = kv & 63;
            v2u w; w.x = pk2(kx[j].x, kx[j].y); w.y = pk2(kx[j].z, kx[j].w);
            *(LAS v2u*)(F.lds + MEM_K_OFF + t * KT128 + (c4 >> 1) * KPB + kl * 16 + (c4 & 1) * 8) = w;
            v2u wv_; wv_.x = pk2(vx[j].x, vx[j].y); wv_.y = pk2(vx[j].z, vx[j].w);
            *(LAS v2u*)(F.lds + MEM_V_OFF + t * VT128 + v_off<128>(kl, c4 >> 1) + (c4 & 1) * 8) = wv_; }
    }
    __syncthreads();
    q_prefetch(F, qid, qs);
    LAS float* mbuf = (LAS float*)(F.lds + MEM_END);
    if (F.wave < 4) {
        const int r32 = lane_ & 31; const size_t row = (size_t)MP + b * SS + (r32 & 7);
        bf16x8 qf[8]; load_q<128>(qf, Z + row * D + TOKW + hd * 128, g_mem_q, C2MEM, r32 < 8, lane_);
        AttnSt<128> S; attn_init<128>(S); S.m = 0.f;
        attn_tile<128, false, false, true>(S, F.lds + MEM_K_OFF + F.wave * KT128, F.lds + MEM_V_OFF + F.wave * VT128, qf, nullptr, 0, 0, 64, lane_);
        merge_write<128>(S, mbuf, 4, F.wave, lane_);
    }
    __syncthreads();
    { const int q = tid_ >> 6, d = 2 * (tid_ & 63); const float o0 = merge_read<128>(mbuf, 4, q, d), o1 = merge_read<128>(mbuf, 4, q, d + 1);
      *(unsigned*)(MIXB + ((size_t)MP + b * SS + q) * D + TOKW + hd * 128 + d) = pk2(o0, o1); }
}

__device__ __forceinline__ float block_excl4(Frame& F, float tsum, LAS float* wtot) {
    float inc = tsum;
#pragma unroll
    for (int o = 1; o < 64; o <<= 1) { const float y = __shfl_up(inc, o); if (F.lane >= o) inc += y; }
    if (F.lane == 63) wtot[F.wave] = inc;
    __syncthreads();
    float off = 0.f;
    for (int w = 0; w < F.wave; ++w) off += wtot[w];
    return off + inc - tsum;
}

constexpr int PF_BUF = 18432, PF_NB_OFF = EPX_OFF, PF_WT_OFF = EPX_OFF + 8192;
__device__ __forceinline__ void unit_pf(Frame& F, QState& qs, int qid, int b, int h, int qb) {
    int tid_ = F.tid, lane_ = F.lane; asm volatile("" : "+v"(tid_), "+v"(lane_));
    const bf16* KB = (const bf16*)(F.ws + F_KB); const bf16* VB = (const bf16*)(F.ws + F_VB); const bf16* Z1 = (const bf16*)(F.ws + F_Z1B); bf16* MIXB = (bf16*)(F.ws + F_MIXB) + (size_t)M * D;
    LAS float* nb = (LAS float*)(F.lds + PF_NB_OFF);
    const int NT = 4 * (qb + 1), kv = tid_ >> 3, c = tid_ & 7;
    const size_t gbase = ((size_t)b * PS + kv) * TOKW + h * 64 + 8 * c;
    v4u kr0 = *(const v4u*)(KB + gbase), vr0 = *(const v4u*)(VB + gbase);
    v4u kr1 = *(const v4u*)(KB + gbase + (size_t)64 * TOKW), vr1 = *(const v4u*)(VB + gbase + (size_t)64 * TOKW);
    {
        const float* lf = F.O.lf_p + ((size_t)b * PS + 4 * tid_) * 8 + h;
        const float a0 = lf[0], a1 = lf[8], a2 = lf[16], a3 = lf[24];
        const float ex = block_excl4(F, (a0 + a1) + (a2 + a3), (LAS float*)(F.lds + PF_WT_OFF));
        const float c0 = ex + a0, c1 = c0 + a1, c2 = c1 + a2, c3 = c2 + a3;
        *(LAS f32x4*)(nb + 4 * tid_) = (f32x4){-c0 * LOG2E, -c1 * LOG2E, -c2 * LOG2E, -c3 * LOG2E};
    }
    *(LAS v4u*)(F.lds + c * KPB + kv * 16) = kr0; *(LAS v4u*)(F.lds + KT64 + v_off<64>(kv, c)) = vr0;
    const int r32 = lane_ & 31, qw0 = qb * 256 + F.wave * 32, qpos = qw0 + r32; const size_t row = (size_t)b * PS + qpos;
    bf16x8 qf[4]; load_q<64>(qf, Z1 + row * D + h * 64, F.in[27], C2FOX, true, lane_);
    AttnSt<64> S; attn_init<64>(S);
    __syncthreads();
    S.m = nb[qpos];
#define PF_TILE(t_) do { const LAS unsigned char* Kt = F.lds + ((t_) & 1) * PF_BUF; if (64 * (t_) <= qw0 + 31) { \
            if (64 * (t_) + 63 > qw0) attn_tile<64, true, true, true>(S, Kt, Kt + KT64, qf, nb + 64 * (t_), 64 * (t_), qpos, 64, lane_); \
            else attn_tile<64, true, false, true>(S, Kt, Kt + KT64, qf, nb + 64 * (t_), 64 * (t_), qpos, 64, lane_); } } while (0)
#pragma unroll 1
    for (int t = 0; t < NT; t += 2) {
        if (t == NT - 4) q_prefetch(F, qid, qs);
        if (t + 2 < NT) { kr0 = *(const v4u*)(KB + gbase + (size_t)(t + 2) * 64 * TOKW); vr0 = *(const v4u*)(VB + gbase + (size_t)(t + 2) * 64 * TOKW); }
        PF_TILE(t);
        { LAS unsigned char* Kn = F.lds + PF_BUF; *(LAS v4u*)(Kn + c * KPB + kv * 16) = kr1; *(LAS v4u*)(Kn + KT64 + v_off<64>(kv, c)) = vr1; }
        __syncthreads();
        if (t + 3 < NT) { kr1 = *(const v4u*)(KB + gbase + (size_t)(t + 3) * 64 * TOKW); vr1 = *(const v4u*)(VB + gbase + (size_t)(t + 3) * 64 * TOKW); }
        PF_TILE(t + 1);
        if (t + 2 < NT) { *(LAS v4u*)(F.lds + c * KPB + kv * 16) = kr0; *(LAS v4u*)(F.lds + KT64 + v_off<64>(kv, c)) = vr0; }
        __syncthreads();
    }
#undef PF_TILE
    store_o<64>(S, MIXB + row * D + h * 64, lane_);
}

constexpr int SF_WTILE = KT64 + VT64  , SF_NB_OFF = 8 * SF_WTILE  , SF_WT_OFF = SF_NB_OFF + 2112 * 4, SF_Q_OFF = SF_WT_OFF + 64;
static_assert(SF_Q_OFF + 8 * 1024 <= LCTL_OFF, "SF LDS map");
__device__ __forceinline__ void unit_sf(Frame& F, QState& qs, int qid, int b, int h) {
    int tid_ = F.tid, lane_ = F.lane; asm volatile("" : "+v"(tid_), "+v"(lane_));
    const float* CKc = F.in[5]; const float* CVc = F.in[6]; const float* CLF = F.in[7]; const int* PT = (const int*)F.in[8] + b * NPAGES;
    const bf16* KB = (const bf16*)(F.ws + F_KB); const bf16* VB = (const bf16*)(F.ws + F_VB); const bf16* Z1 = (const bf16*)(F.ws + F_Z1B); bf16* MIXB = (bf16*)(F.ws + F_MIXB) + (size_t)M * D;
    LAS float* nb = (LAS float*)(F.lds + SF_NB_OFF);
    LAS unsigned char* Kt = F.lds + F.wave * SF_WTILE; LAS unsigned char* Vt = Kt + KT64;
    const int rsub = lane_ >> 4, c4 = lane_ & 15;
    f32x4 kx[2][8], vx[2][8];
#define SF_BASE(pg, tile, hf) ((((size_t)(pg) * PAGE + ((tile) & 1) * 64 + (hf) * 32) * 8 + h) * 64 + 4 * c4 + (size_t)rsub * 512)
#define SF_ISSUE(set, pg, tile, hf) do { const size_t o_ = SF_BASE(pg, tile, hf); _Pragma("unroll") for (int j = 0; j < 8; ++j) { kx[set][j] = __builtin_nontemporal_load((const f32x4*)(CKc + o_ + (size_t)j * 4 * 512)); vx[set][j] = __builtin_nontemporal_load((const f32x4*)(CVc + o_ + (size_t)j * 4 * 512)); } } while (0)
#define SF_WRITE(set, hf) do { _Pragma("unroll") for (int j = 0; j < 8; ++j) { const int kv = (hf) * 32 + 4 * j + rsub; v2u w; w.x = pk2(kx[set][j].x, kx[set][j].y); w.y = pk2(kx[set][j].z, kx[set][j].w); \
            *(LAS v2u*)(Kt + (c4 >> 1) * KPB + kv * 16 + (c4 & 1) * 8) = w; \
            v2u wv_; wv_.x = pk2(vx[set][j].x, vx[set][j].y); wv_.y = pk2(vx[set][j].z, vx[set][j].w); *(LAS v2u*)(Vt + v_off<64>(kv, c4 >> 1) + (c4 & 1) * 8) = wv_; } } while (0)
    int pgc = PT[F.wave >> 1];
    SF_ISSUE(0, pgc, F.wave, 0); SF_ISSUE(1, pgc, F.wave, 1);
    const int r32 = lane_ & 31; const size_t qrow = (size_t)MP + b * SS + (r32 & 7);
    LAS unsigned char* qlds = F.lds + SF_Q_OFF + F.wave * 1024 + ((lane_ >> 5) * 8 + (r32 & 7)) * 16;
    {
        const int s0 = 4 * tid_, pg = PT[s0 >> 7]; const float* lf = CLF + ((size_t)pg * PAGE + (s0 & 127)) * 8 + h;
        const float a0 = lf[0], a1 = lf[8], a2 = lf[16], a3 = lf[24];
        const float lnew = (tid_ >= 504) ? F.O.lf_s[((size_t)b * SS + (tid_ - 504)) * 8 + h] : 0.f;
        bf16x8 q0[4]; load_q<64>(q0, Z1 + qrow * D + h * 64, F.in[27], C2FOX, r32 < 8, lane_);
        if (r32 < 8) {
#pragma unroll
            for (int d0 = 0; d0 < 4; ++d0) *(LAS bf16x8*)(qlds + d0 * 256) = q0[d0]; }
        const float ex = block_excl4(F, (a0 + a1) + (a2 + a3), (LAS float*)(F.lds + SF_WT_OFF));
        const float c0 = ex + a0, c1 = c0 + a1, c2 = c1 + a2, c3 = c2 + a3;
        *(LAS f32x4*)(nb + s0) = (f32x4){-c0 * LOG2E, -c1 * LOG2E, -c2 * LOG2E, -c3 * LOG2E};
        if (F.wave == 7) {
            const float tot = __shfl(c3, 63); float inc = lnew;
#pragma unroll
            for (int o = 1; o < 8; o <<= 1) { const float y = __shfl_up(inc, o); if (lane_ >= 56 + o) inc += y; }
            if (lane_ >= 56) nb[PAST + lane_ - 56] = -(tot + inc) * LOG2E; else nb[PAST + 8 + lane_] = -tot * LOG2E; }
    }
    __syncthreads();
    AttnSt16 S; attn_init16(S, nb[PAST + (((lane_ & 15) < SS) ? (lane_ & 15) : SS - 1)]);
    const LAS unsigned char* qpark = F.lds + SF_Q_OFF + F.wave * 1024;
#pragma unroll 1
    for (int tt = 0; tt < 4; ++tt) {
        const int tile = F.wave + 8 * tt; const int pgn = (tt + 1 < 4) ? PT[(tile + 8) >> 1] : 0;
        SF_WRITE(0, 0);
        if (tt + 1 < 4) SF_ISSUE(0, pgn, tile + 8, 0);
        SF_WRITE(1, 1);
        if (tt + 1 < 4) SF_ISSUE(1, pgn, tile + 8, 1);
        attn_tile16<false>(S, Kt, Vt, qpark, nb + 64 * tile, 64 * tile, PAST + (lane_ & 15), 64, lane_);
    }
#undef SF_WRITE
#undef SF_ISSUE
#undef SF_BASE
    q_prefetch(F, qid, qs);
    if (F.wave == 0) {
        for (int i = lane_; i < SF_WTILE / 16; i += 64) *(LAS v4u*)(Kt + i * 16) = (v4u){0u, 0u, 0u, 0u};
        const int kv = lane_ >> 3, c = lane_ & 7; const size_t g = ((size_t)MP + b * SS + kv) * TOKW + h * 64 + 8 * c;
        const v4u kr = *(const v4u*)(KB + g), vr = *(const v4u*)(VB + g);
        *(LAS v4u*)(Kt + c * KPB + kv * 16) = kr; *(LAS v4u*)(Vt + v_off<64>(kv, c)) = vr;
        attn_tile16<true>(S, Kt, Vt, qpark, nb + PAST, PAST, PAST + (lane_ & 15), SS, lane_);
    }
    __syncthreads();
    LAS float* mbuf = (LAS float*)(F.lds);
    merge_write16(S, mbuf, 8, F.wave, lane_);
    __syncthreads();
    { const int q = tid_ >> 6, d = tid_ & 63; const float o = merge_read<64>(mbuf, 8, q, d);
      const float o1 = __shfl_xor(o, 1);
      if ((d & 1) == 0) *(unsigned*)(MIXB + ((size_t)MP + b * SS + q) * D + h * 64 + d) = pk2(o, o1); }
}

constexpr int PL_E_OFF = 0, PL_E_PITCH = 256, PL_Y_OFF = 98304, PL_Y_PITCH = 272;
__device__ __forceinline__ void unit_pl(Frame& F, QState& qs, int qid, int j, int g) {
    int tid_ = F.tid, lane_ = F.lane; asm volatile("" : "+v"(tid_), "+v"(lane_));
    const bf16* ZB = (const bf16*)(F.ws + F_ZB); bf16* MIXB = (bf16*)(F.ws + F_MIXB); const bf16* WP = (const bf16*)(F.ws + F_WPOOL) + (size_t)g * 128 * 128;
    const float* state = F.in[4];
    const int w = 2 << g; const bool smp = j >= 128;
    LAS unsigned char* E = F.lds + PL_E_OFF;
    bf16x8 wf[4];
#pragma unroll
    for (int ks = 0; ks < 4; ++ks) wf[ks] = *(const bf16x8*)(WP + (size_t)(16 * F.wave + (lane_ & 15)) * 128 + 32 * ks + 8 * (lane_ >> 4));
    if (!smp) {
        const int b = j >> 4, s0 = (j & 15) * 128;
        v4u ev[5];
#pragma unroll
        for (int q = 0; q < 5; ++q) { const int i = tid_ + 512 * q, e = i >> 4, ch = i & 15, pos = s0 - 15 + e; ev[q] = (v4u){0u, 0u, 0u, 0u};
            if (i < 143 * 16 && pos >= 0) ev[q] = *(const v4u*)(ZB + ((size_t)b * PS + pos) * D + g * 128 + 8 * ch); }
#pragma unroll
        for (int q = 0; q < 5; ++q) { const int i = tid_ + 512 * q; if (i < 143 * 16) *(LAS v4u*)(E + (i >> 4) * PL_E_PITCH + (i & 15) * 16) = ev[q]; }
    } else {
        const int b0 = (j - 128) * 16;
        for (int i = tid_; i < 16 * 23 * 16; i += 512) { const int e = i >> 4, ch = i & 15, bi = e / 23, k = e % 23, b = b0 + bi; v4u v;
            if (k < 15) { const float* sp = state + ((size_t)b * 15 + k) * TOKW + g * 128 + 8 * ch; const f32x4 x0 = *(const f32x4*)sp, x1 = *(const f32x4*)(sp + 4);
                v.x = pk2(x0.x, x0.y); v.y = pk2(x0.z, x0.w); v.z = pk2(x1.x, x1.y); v.w = pk2(x1.z, x1.w); }
            else v = *(const v4u*)(ZB + ((size_t)MP + b * SS + (k - 15)) * D + g * 128 + 8 * ch);
            *(LAS v4u*)(E + e * PL_E_PITCH + ch * 16) = v; }
    }
    __syncthreads();
    {
        const int cp = tid_ & 63, rq = tid_ >> 6;
#define PL_SEG(W) do { _Pragma("unroll") for (int sg_ = 0; sg_ < 2; ++sg_) { const int tl0 = rq * 16 + sg_ * 8; const int e0 = smp ? (2 * rq + sg_) * 23 + 15 : 15 + tl0; \
            float x0[(W) + 7], x1[(W) + 7]; \
            _Pragma("unroll") for (int k = 0; k < (W) + 7; ++k) { const unsigned x = *(const LAS unsigned*)(E + (e0 - ((W) - 1) + k) * PL_E_PITCH + cp * 4); x0[k] = bf_lo(x); x1[k] = bf_hi(x); } \
            float s0 = 0.f, s1 = 0.f; \
            _Pragma("unroll") for (int k = 0; k < (W) - 1; ++k) { s0 += x0[k]; s1 += x1[k]; } \
            _Pragma("unroll") for (int i = 0; i < 8; ++i) { s0 += x0[(W) - 1 + i]; s1 += x1[(W) - 1 + i]; \
                float ic = 1.0f / (float)(W); if (!smp) { const int s = (j & 15) * 128 + tl0 + i; if (s + 1 < (W)) ic = 1.0f / (float)(s + 1); } \
                *(LAS unsigned*)(F.lds + PL_Y_OFF + (tl0 + i) * PL_Y_PITCH + cp * 4) = pk2(s0 * ic - x0[(W) - 1 + i], s1 * ic - x1[(W) - 1 + i]); \
                s0 -= x0[i]; s1 -= x1[i]; } } } while (0)
        if (g == 0) PL_SEG(2); else if (g == 1) PL_SEG(4); else if (g == 2) PL_SEG(8); else PL_SEG(16);
#undef PL_SEG
    }
    __syncthreads();
    q_prefetch(F, qid, qs);
    {
        const int r = lane_ & 15, kq = lane_ >> 4;
        const size_t obase = smp ? (size_t)MP + (j - 128) * 128 : (size_t)j * 128;
#pragma unroll
        for (int nb = 0; nb < 8; ++nb) { f32x4 acc = {0.f, 0.f, 0.f, 0.f};
#pragma unroll
            for (int ks = 0; ks < 4; ++ks) { const bf16x8 af = *(const LAS bf16x8*)(F.lds + PL_Y_OFF + (16 * nb + r) * PL_Y_PITCH + (32 * ks + 8 * kq) * 2);
                acc = __builtin_amdgcn_mfma_f32_16x16x32_bf16(wf[ks], af, acc, 0, 0, 0); }
            v2u o; o.x = pk2(acc[0], acc[1]); o.y = pk2(acc[2], acc[3]);
            *(v2u*)(MIXB + (obase + 16 * nb + r) * D + g * 128 + 16 * F.wave + 4 * kq) = o; }
    }
}

__device__ __forceinline__ void pool_state_job(Frame& F) {
    const bf16* ZB = (const bf16*)(F.ws + F_ZB); const float* state = F.in[4];
    constexpr int NP4 = PB * 15 * TOKW / 4, NS4 = SB * 15 * TOKW / 4;
    for (int i = blockIdx.x * 512 + F.tid; i < NP4 + NS4; i += F.G * 512) {
        if (i < NP4) { const int b = i / (15 * 128), r = (i / 128) % 15, c4 = i % 128; const v2u x = *(const v2u*)(ZB + ((size_t)b * PS + PS - 15 + r) * D + 4 * c4);
            *(f32x4*)(F.O.ps_p + (size_t)i * 4) = (f32x4){bf_lo(x.x), bf_hi(x.x), bf_lo(x.y), bf_hi(x.y)}; }
        else { const int k = i - NP4, b = k / (15 * 128), r = (k / 128) % 15, c4 = k % 128, e = r + SS; f32x4 o;
            if (e < 15) o = *(const f32x4*)(state + ((size_t)b * 15 + e) * TOKW + 4 * c4);
            else { const v2u x = *(const v2u*)(ZB + ((size_t)MP + b * SS + (e - 15)) * D + 4 * c4); o = (f32x4){bf_lo(x.x), bf_hi(x.x), bf_lo(x.y), bf_hi(x.y)}; }
            *(f32x4*)(F.O.ps_s + (size_t)k * 4) = o; }
    }
}

__device__ __forceinline__ void logf_job(Frame& F) {
    int tid_ = F.tid, lane_ = F.lane; asm volatile("" : "+v"(tid_), "+v"(lane_));
    const bf16* HB = (const bf16*)(F.ws + F_HB) + (size_t)1 * M * D; const float* WFG = (const float*)(F.ws + F_WFG); const float* SS = (const float*)(F.ws + F_SSH) + (size_t)1 * M * 16; const float* b_fg = F.in[26];
    const int c = lane_ & 15, rs = lane_ >> 4, kbase = 128 * F.wave + 8 * c;
    const bool b3 = (c & 8) != 0, b2 = (c & 4) != 0, b1 = (c & 2) != 0;
    f32x4 wv[8][2];
#pragma unroll
    for (int hh = 0; hh < 8; ++hh) { wv[hh][0] = *(const f32x4*)(WFG + (size_t)hh * D + kbase); wv[hh][1] = *(const f32x4*)(WFG + (size_t)hh * D + kbase + 4); }
    LAS float* part = (LAS float*)F.lds;
    constexpr int NSLOT = 17, NROW = 4 * NSLOT;
    const int nr = (M - (int)blockIdx.x + F.G - 1) / F.G;
#pragma unroll 1
    for (int i0 = 0; i0 < nr; i0 += NROW) {
        __syncthreads();
        v4u x[NSLOT];
#pragma unroll
        for (int sl = 0; sl < NSLOT; ++sl) { const int i = i0 + 4 * sl + rs; x[sl] = (v4u){0u, 0u, 0u, 0u};
            if (i < nr) x[sl] = *(const v4u*)(HB + (size_t)(blockIdx.x + F.G * i) * D + kbase); }
#pragma unroll
        for (int sl = 0; sl < NSLOT; ++sl) {
            const float e0 = bf_lo(x[sl].x), e1 = bf_hi(x[sl].x), e2 = bf_lo(x[sl].y), e3 = bf_hi(x[sl].y), e4 = bf_lo(x[sl].z), e5 = bf_hi(x[sl].z), e6 = bf_lo(x[sl].w), e7 = bf_hi(x[sl].w);
            float sh[8];
#pragma unroll
            for (int hh = 0; hh < 8; ++hh) sh[hh] = (e0 * wv[hh][0].x + e1 * wv[hh][0].y) + (e2 * wv[hh][0].z + e3 * wv[hh][0].w) + (e4 * wv[hh][1].x + e5 * wv[hh][1].y) + (e6 * wv[hh][1].z + e7 * wv[hh][1].w);
            float t4[4], t2[2];
#pragma unroll
            for (int hh = 0; hh < 4; ++hh) { const float keep = b3 ? sh[hh + 4] : sh[hh], send = b3 ? sh[hh] : sh[hh + 4]; t4[hh] = keep + __shfl_xor(send, 8); }
#pragma unroll
            for (int hh = 0; hh < 2; ++hh) { const float keep = b2 ? t4[hh + 2] : t4[hh], send = b2 ? t4[hh] : t4[hh + 2]; t2[hh] = keep + __shfl_xor(send, 4); }
            float t1; { const float keep = b1 ? t2[1] : t2[0], send = b1 ? t2[0] : t2[1]; t1 = keep + __shfl_xor(send, 2); }
            t1 += __shfl_xor(t1, 1);
            if ((c & 1) == 0) part[(F.wave * NROW + 4 * sl + rs) * 8 + (c >> 1)] = t1;
        }
        __syncthreads();
        for (int o = tid_; o < NROW * 8; o += NWAVES * 64) { const int il = o >> 3, hh = o & 7, i = i0 + il;
            if (i < nr) { const int row = blockIdx.x + F.G * i; float sum = 0.f;
#pragma unroll
                for (int w = 0; w < 8; ++w) sum += part[(w * NROW + il) * 8 + hh];
                const float xv = sum * row_rstd(SS, 16, row) + b_fg[hh]; const float r = fminf(xv, 0.f) - log1pf(__expf(-fabsf(xv)));
                if (row < MP) F.O.lf_p[(size_t)row * 8 + hh] = r; else F.O.lf_s[(size_t)(row - MP) * 8 + hh] = r; } }
    }
}
constexpr int N_PHASES = 11;
__global__ void __launch_bounds__(NWAVES * 64, 2) mega_fwd(Args args) {
    extern __shared__ __attribute__((aligned(16))) unsigned char lds[];
    Frame F;
    F.lds = (LAS unsigned char*)lds;
    F.MISC = (volatile LAS unsigned*)(F.lds + LCTL_OFF);
    F.tid = threadIdx.x; F.lane = F.tid & 63; F.wave = __builtin_amdgcn_readfirstlane(F.tid >> 6);
    F.G = gridDim.x; F.ws = args.ws; F.ctl = (gu32*)(args.ws + F_CTL);
#pragma unroll
    for (int i = 0; i < 28; ++i) F.in[i] = args.in[i];
    F.O = carve_out(args.out);
    for (int u = F.tid; u < (LDS_BYTES - LCTL_OFF) / 4; u += NWAVES * 64) ((LAS unsigned*)(F.lds + LCTL_OFF))[u] = 0u;
    __syncthreads();
    const int lo = args.ph_lo, hi = args.ph_hi;
    const bool one = (hi - lo) > 1;
    XcdBarrier bar; bar.bar = (unsigned*)(F.ctl + CW_BAR); bar.x = 0; bar.st = nullptr;
    if (one) bar = xcd_barrier_post((unsigned*)(F.ctl + CW_BAR), F.MISC + 8);
#define IN(k) (lo <= (k) && (k) < hi)
#define SEAM(k) do { if (IN(k) && IN((k) + 1)) xcd_barrier(bar); if (MK_TS >= 0 && (k) + 1 == MK_TS) ts0_ = __builtin_amdgcn_s_memrealtime(); if (MK_TS >= 0 && (k) == MK_TS) ts1_ = __builtin_amdgcn_s_memrealtime(); } while (0)
    unsigned long long ts0_ = (MK_TS == 0 || MK_TS == 99) ? __builtin_amdgcn_s_memrealtime() : 0ull, ts1_ = 0;
    unsigned char* ws = args.ws;
    bf16* XB = (bf16*)(ws + F_XB); bf16* MEMB = (bf16*)(ws + F_MEMB); bf16* ZB = (bf16*)(ws + F_ZB); bf16* Z1B = (bf16*)(ws + F_Z1B); bf16* MIXB = (bf16*)(ws + F_MIXB);
    bf16* HB = (bf16*)(ws + F_HB); float* HF = (float*)(ws + F_HF); bf16* ACTB = (bf16*)(ws + F_ACTB); bf16* KB = (bf16*)(ws + F_KB); bf16* VB = (bf16*)(ws + F_VB);
    bf16* MKB = (bf16*)(ws + F_MKB); bf16* MVB = (bf16*)(ws + F_MVB); float* SS0 = (float*)(ws + F_SS0); float* SSM = (float*)(ws + F_SSM); float* SSH = (float*)(ws + F_SSH);
    bf16* WIN0 = (bf16*)(ws + F_WIN0); bf16* W6 = (bf16*)(ws + F_W6); bf16* WOUT = (bf16*)(ws + F_WOUT); bf16* WGU = (bf16*)(ws + F_WGU); bf16* WDOWN = (bf16*)(ws + F_WDOWN); bf16* WMEM = (bf16*)(ws + F_WMEM);
    const size_t MD = (size_t)M * D;

    if (IN(0)) { _Pragma("unroll") for (int rep = 0; rep < ((MK_DUP >> 0) & 1) + 1; ++rep) { p0_prologue(F); } }
    SEAM(0);
    if (IN(1)) { _Pragma("unroll") for (int rep = 0; rep < ((MK_DUP >> 1) & 1) + 1; ++rep) {
        { pg8::Gemm g{XB, WIN0, MP, D, D}; pg8::StaticOrder S; S.init(MP, D, F.G, (int)blockIdx.x);
          fill_rstd_table(F.lds, S, SS0, 1, F.tid);
          epi::ScaleBf16 E{ZB, D, (const LAS float*)(F.lds + RT_OFF)};
          pg8::gemm_phase<epi::ScaleBf16, pg8::StaticOrder, true, true>(F.lds, g, S, E); }
        { const sg::EScale E{ZB, D, SS0, 1};
          for (int t = blockIdx.x; t < 256; t += F.G) sg::small_gemm(F, XB + (size_t)MP * D, WIN0, D, t >> 4, t & 15, MP, sg::MapId{}, E); }
        { const sg::EMemKV E{MKB, MVB, F.O.mv_p, SSM, 0};
          for (int t = blockIdx.x; t < 256; t += F.G) sg::small_gemm<2>(F, MEMB, WMEM, D, t >> 4, t & 15, 0, sg::MapId{}, E); }
    } }
    SEAM(1);
    if (IN(2)) { _Pragma("unroll") for (int rep = 0; rep < ((MK_DUP >> 2) & 1) + 1; ++rep) {
        pool_state_job(F);
        QState qs; for (int u = q_first(F, 0 + 2 * rep, qs); u < 1312; u = q_advance(F, qs)) { const int qid = 0 + 2 * rep;
            if (u < 768) { const int k = u / 3, r = u % 3;
                if (r == 0) { unit_pm(F, qs, qid, 0, k >> 5, (k >> 3) & 3, k & 7); if (MK_DUPU & 32) { __syncthreads(); QState dq_; unit_pm(F, dq_, 15, 0, k >> 5, (k >> 3) & 3, k & 7); } }
                else { const int i = 2 * k + r - 1; unit_sm(F, qs, qid, 0, i >> 2, i & 3); if (MK_DUPU & 16) { __syncthreads(); QState dq_; unit_sm(F, dq_, 15, 0, i >> 2, i & 3); } } }
            else { const int i = u - 768; unit_pl(F, qs, qid, i >> 2, i & 3); if (MK_DUPU & 64) { __syncthreads(); QState dq_; unit_pl(F, dq_, 15, i >> 2, i & 3); } } }
    } }
    SEAM(2);
    if (IN(3)) { _Pragma("unroll") for (int rep = 0; rep < ((MK_DUP >> 3) & 1) + 1; ++rep) {
        { pg8::Gemm g{MIXB, WOUT, MP, D, D}; pg8::StaticOrder S; S.init(MP, D, F.G, (int)blockIdx.x);
          epi::Resid E{XB, HB, nullptr, SSH};
          pg8::gemm_phase<epi::Resid, pg8::StaticOrder, true, true>(F.lds, g, S, E); }
        { const sg::EResid E{XB, HB, nullptr, SSH};
          for (int t = blockIdx.x; t < 256; t += F.G) sg::small_gemm(F, MIXB + (size_t)MP * D, WOUT, D, t >> 4, t & 15, MP, sg::MapId{}, E); }
    } }
    SEAM(3);
    if (IN(4)) { _Pragma("unroll") for (int rep = 0; rep < ((MK_DUP >> 4) & 1) + 1; ++rep) {
#if MK_NULLEPI
        if (rep == 0) { pg8::Gemm g{HB, WGU, M, 2 * FF, D}; pg8::StaticOrder S; S.init(M, 2 * FF, F.G, (int)blockIdx.x);
          epi::Null E{(float*)(ws + F_SSH + (size_t)3 * M * 16 * 4 - 1048576)};
          pg8::gemm_phase<epi::Null, pg8::StaticOrder, true, true>(F.lds, g, S, E); } else
#endif
        { pg8::Gemm g{HB, WGU, M, 2 * FF, D}; pg8::StaticOrder S; S.init(M, 2 * FF, F.G, (int)blockIdx.x);
          fill_rstd_table(F.lds, S, SSH, 16, F.tid);
          epi::Swiglu E{ACTB, (const LAS float*)(F.lds + RT_OFF)};
          pg8::gemm_phase<epi::Swiglu, pg8::StaticOrder, true, true>(F.lds, g, S, E); }
        { pg8::Gemm g{MEMB, WMEM + (size_t)D * D, MEMROWS, D, D}; pg8::StaticOrder S; S.init(MEMROWS, D, F.G, (int)((blockIdx.x + 40) % F.G));
          fill_rstd_table(F.lds, S, SSM, 1, F.tid);
          epi::MemKV E{MKB, MVB, F.O.mv_p, (const LAS float*)(F.lds + RT_OFF), 1};
          pg8::gemm_phase<epi::MemKV, pg8::StaticOrder, true, true>(F.lds, g, S, E); }
    } }
    SEAM(4);
    if (IN(5)) { _Pragma("unroll") for (int rep = 0; rep < ((MK_DUP >> 5) & 1) + 1; ++rep) {
        { pg8::Gemm g{ACTB, WDOWN, MP, D, FF}; pg8::StaticOrder S; S.init(MP, D, F.G, (int)blockIdx.x);
          epi::Resid E{HB, HB + MD, nullptr, SSH + (size_t)M * 16};
          pg8::gemm_phase<epi::Resid, pg8::StaticOrder, true, true>(F.lds, g, S, E); }
        { const sg::EResid E{HB, HB + MD, nullptr, SSH + (size_t)M * 16};
          for (int t = blockIdx.x; t < 256; t += F.G) sg::small_gemm(F, ACTB + (size_t)MP * FF, WDOWN, FF, t >> 4, t & 15, MP, sg::MapId{}, E); }
    } }
    SEAM(5);
    if (IN(6)) { _Pragma("unroll") for (int rep = 0; rep < ((MK_DUP >> 6) & 1) + 1; ++rep) {
        { pg8::Gemm g{HB + MD, W6, MP, 2 * D, D}; pg8::StaticOrder S; S.init(MP, 2 * D, F.G, (int)blockIdx.x);
          if (F.tid < 64) ((LAS float*)(F.lds + RT_OFF))[2048 + F.tid] = F.in[24][F.tid];
          fill_rstd_table(F.lds, S, SSH + (size_t)M * 16, 16, F.tid);
          epi::KVQ E{KB, VB, Z1B, F.O.k_p, F.O.k_s, F.O.v_p, F.O.v_s, F.in[24], (const LAS float*)(F.lds + RT_OFF)};
          pg8::gemm_phase<epi::KVQ, pg8::StaticOrder, true, true>(F.lds, g, S, E); }
        { const sg::EKVQ E{KB, VB, Z1B, F.O.k_s, F.O.v_s, F.in[24], SSH + (size_t)M * 16};
          for (int t = blockIdx.x; t < 256; t += F.G) sg::small_gemm<2>(F, HB + MD + (size_t)MP * D, W6, D, t >> 5, t & 31, MP, sg::MapHead64{}, E); }
        logf_job(F); if (MK_DUPS & 1) logf_job(F);
#if MK_STREAM_PROBE
        {
            f32x4 a0 = {0.f, 0.f, 0.f, 0.f}, a1 = a0, a2 = a0, a3 = a0; const size_t n = (size_t)2560 * 128 * 512 / 4, stride = (size_t)F.G * 512;
            for (int w = 0; w < 2; ++w) { const f32x4* p = (const f32x4*)F.in[5 + w];
                for (size_t i = (size_t)blockIdx.x * 512 + F.tid; i + 7 * stride < n; i += 8 * stride) {
                    const f32x4 x0 = p[i], x1 = p[i + stride], x2 = p[i + 2 * stride], x3 = p[i + 3 * stride], x4 = p[i + 4 * stride], x5 = p[i + 5 * stride], x6 = p[i + 6 * stride], x7 = p[i + 7 * stride];
                    a0 += x0 + x4; a1 += x1 + x5; a2 += x2 + x6; a3 += x3 + x7; } }
            const f32x4 s = (a0 + a1) + (a2 + a3);
            ((float*)(F.ws + F_SSH + (size_t)3 * M * 16 * 4 - 1048576))[blockIdx.x * 512 + F.tid] = s.x + s.y + s.z + s.w;
        }
#endif
    } }
    SEAM(6);
    if (IN(7)) { _Pragma("unroll") for (int rep = 0; rep < ((MK_DUP >> 7) & 1) + 1; ++rep) {
        QState qs; for (int u = q_first(F, 1 + 2 * rep, qs); u < 2304; u = q_advance(F, qs)) { const int qid = 1 + 2 * rep;
            if (u < 1536) { const int k = u / 3, r = u % 3;
                if (r < 2) { const int i = 2 * k + r; unit_sf(F, qs, qid, i >> 3, i & 7); if (MK_DUPU & 1) { __syncthreads(); QState dq_; unit_sf(F, dq_, 15, i >> 3, i & 7); } }
                else { const int i = k; unit_pf(F, qs, qid, (i & 63) >> 3, i & 7, 7 - (i >> 6)); if (MK_DUPU & 2) { __syncthreads(); QState dq_; unit_pf(F, dq_, 15, (i & 63) >> 3, i & 7, 7 - (i >> 6)); } } }
            else { const int v = u - 1536, k = v / 3, r = v % 3;
                if (r < 2) { const int i = 2 * k + r; unit_sm(F, qs, qid, 1, i >> 2, i & 3); if (MK_DUPU & 4) { __syncthreads(); QState dq_; unit_sm(F, dq_, 15, 1, i >> 2, i & 3); } }
                else { unit_pm(F, qs, qid, 1, k >> 5, (k >> 3) & 3, k & 7); if (MK_DUPU & 8) { __syncthreads(); QState dq_; unit_pm(F, dq_, 15, 1, k >> 5, (k >> 3) & 3, k & 7); } } } }
    } }
    SEAM(7);
    if (IN(8)) { _Pragma("unroll") for (int rep = 0; rep < ((MK_DUP >> 8) & 1) + 1; ++rep) {
        { pg8::Gemm g{MIXB + MD, WOUT + (size_t)D * D, MP, D, D}; pg8::StaticOrder S; S.init(MP, D, F.G, (int)blockIdx.x);
          epi::Resid E{HB + MD, HB + 2 * MD, nullptr, SSH + (size_t)2 * M * 16};
          pg8::gemm_phase<epi::Resid, pg8::StaticOrder, true, true>(F.lds, g, S, E); }
        { const sg::EResid E{HB + MD, HB + 2 * MD, nullptr, SSH + (size_t)2 * M * 16};
          for (int t = blockIdx.x; t < 256; t += F.G) sg::small_gemm(F, MIXB + MD + (size_t)MP * D, WOUT + (size_t)D * D, D, t >> 4, t & 15, MP, sg::MapId{}, E); }
    } }
    SEAM(8);
#if MK_XBAR
    if (one) { for (int i = 0; i < MK_XBAR; ++i) xcd_barrier(bar); }
#endif
    if (IN(9)) { _Pragma("unroll") for (int rep = 0; rep < ((MK_DUP >> 9) & 1) + 1; ++rep) { pg8::Gemm g{HB + 2 * MD, WGU + (size_t)2 * FF * D, M, 2 * FF, D}; pg8::StaticOrder S; S.init(M, 2 * FF, F.G, (int)blockIdx.x);
        fill_rstd_table(F.lds, S, SSH + (size_t)2 * M * 16, 16, F.tid);
        epi::Swiglu E{ACTB + (size_t)M * FF, (const LAS float*)(F.lds + RT_OFF)};
        pg8::gemm_phase<epi::Swiglu, pg8::StaticOrder, true, true>(F.lds, g, S, E); } }
    SEAM(9);
    if (IN(10)) { _Pragma("unroll") for (int rep = 0; rep < ((MK_DUP >> 10) & 1) + 1; ++rep) {
        { pg8::Gemm g{ACTB + (size_t)M * FF, WDOWN + (size_t)D * FF, MP, D, FF}; pg8::StaticOrder S; S.init(MP, D, F.G, (int)blockIdx.x);
          epi::Resid E{HB + 2 * MD, nullptr, F.O.y_p, nullptr};
          pg8::gemm_phase<epi::Resid, pg8::StaticOrder, true, true>(F.lds, g, S, E); }
        { const sg::EResid E{HB + 2 * MD, nullptr, F.O.y_p, nullptr};
          for (int t = blockIdx.x; t < 256; t += F.G) sg::small_gemm(F, ACTB + (size_t)M * FF + (size_t)MP * FF, WDOWN + (size_t)D * FF, FF, t >> 4, t & 15, MP, sg::MapId{}, E); }
    } }
#if MK_TS >= 0
    if (MK_TS == 99) ts1_ = __builtin_amdgcn_s_memrealtime();
    if (blockIdx.x == 0 && F.tid == 0) { asm volatile("s_waitcnt vmcnt(0)" ::: "memory"); args.out[0] = (float)(((ts1_ - ts0_) / 2500ull) * 25ull) * 1.0e6f; }
#endif
#undef IN
#undef SEAM
}

#ifndef MK_DEBUG
#define MK_DEBUG 0
#endif
#ifndef MK_PER_PHASE
#define MK_PER_PHASE 0
#endif
static int mk_grid() {
    static int grid = 0;
    if (grid == 0) {
        int dev = 0, cus = 0, per_cu = 0;
        if (hipGetDevice(&dev) != hipSuccess || hipDeviceGetAttribute(&cus, hipDeviceAttributeMultiprocessorCount, dev) != hipSuccess) { fprintf(stderr, "kernel_launch: device query failed\n"); grid = -1; return grid; }
        if (hipFuncSetAttribute((const void*)mega_fwd, hipFuncAttributeMaxDynamicSharedMemorySize, LDS_BYTES) != hipSuccess) { fprintf(stderr, "kernel_launch: hipFuncSetAttribute failed\n"); grid = -1; return grid; }
        if (hipOccupancyMaxActiveBlocksPerMultiprocessor(&per_cu, (const void*)mega_fwd, NWAVES * 64, LDS_BYTES) != hipSuccess || per_cu < 1) fprintf(stderr, "kernel_launch: occupancy query reports %d\n", per_cu);
        (void)hipGetLastError();
        grid = cus;
    }
    return grid;
}
static void mk_launch(void* const* d_in, float* out, unsigned char* fws, hipStream_t stream) {
    const int grid = mk_grid(); if (grid <= 0) return;
    (void)hipMemsetAsync(fws + F_CTL, 0, CTL_ZERO_BYTES, stream);
    Args a{};
    for (int i = 0; i < 28; ++i) a.in[i] = (const float*)d_in[i];
    a.out = out; a.ws = fws;
#if MK_PER_PHASE
    for (int p = 0; p < N_PHASES; ++p) { a.ph_lo = p; a.ph_hi = p + 1; hipLaunchKernelGGL(mega_fwd, dim3(grid), dim3(NWAVES * 64), LDS_BYTES, stream, a); }
#else
    a.ph_lo = 0; a.ph_hi = N_PHASES; hipLaunchKernelGGL(mega_fwd, dim3(grid), dim3(NWAVES * 64), LDS_BYTES, stream, a);
#endif
    const hipError_t le = hipPeekAtLastError();
    if (le != hipSuccess) fprintf(stderr, "kernel_launch: launch failed: %s\n", hipGetErrorName(le));
}
#if MK_DEBUG
namespace dbg {
constexpr int MAXST = 40;
__global__ void k_cmp(const void* f, int is_bf16, int ldf, const float* n, int ldn, int rows, int cols, double* acc, int st) {
    double d2 = 0.0, n2 = 0.0;
    const size_t tot = (size_t)rows * cols;
    for (size_t i = (size_t)blockIdx.x * blockDim.x + threadIdx.x; i < tot; i += (size_t)gridDim.x * blockDim.x) {
        const size_t r = i / cols; const int c = (int)(i % cols);
        float fv; if (is_bf16) { const unsigned short u = ((const unsigned short*)f)[r * ldf + c]; fv = __builtin_bit_cast(float, (unsigned)u << 16); } else fv = ((const float*)f)[r * ldf + c];
        const float nv_ = n[r * ldn + c];
        double d = (double)fv - (double)nv_; if (!(fv == fv)) d = 1e30;
        d2 += d * d; n2 += (double)nv_ * (double)nv_;
    }
    for (int o = 32; o > 0; o >>= 1) { d2 += __shfl_xor(d2, o); n2 += __shfl_xor(n2, o); }
    if ((threadIdx.x & 63) == 0) { atomicAdd(acc + 2 * st, d2); atomicAdd(acc + 2 * st + 1, n2); }
}
__global__ void k_verdict(const double* acc, int nst, double tol, float* out) {
    if (threadIdx.x != 0 || blockIdx.x != 0) return;
    for (int s = 0; s < nst; ++s) { const double r = acc[2 * s] / (acc[2 * s + 1] + 1e-300);
        if (!(r <= tol)) { int c = 13; if (r == r && r < 1e4) { c = (int)floor(log10(r + 1e-300)) + 9; if (c < 0) c = 0; if (c > 13) c = 13; }
            out[0] = (float)((10.0 + s) * pow(10.0, 5.0 + c)); return; } }
}
template <int MAP> __global__ void k_expw(const float* W, int ldw, int K, int Nphys, const float* gain, const float* cscale, float* E) {
    const size_t tot = (size_t)Nphys * K;
    for (size_t i = (size_t)blockIdx.x * blockDim.x + threadIdx.x; i < tot; i += (size_t)gridDim.x * blockDim.x) {
        const int p = (int)(i / K), k = (int)(i % K); const int sc = src_col<MAP>(p);
        E[i] = W[(size_t)k * ldw + sc] * (gain ? gain[k] : 1.0f) * (cscale ? cscale[sc] : 1.0f);
    }
}
}
#endif

extern "C" void kernel_launch(void* const* d_in, const int* in_sizes, int n_in, void* d_out, int out_size, void* d_ws, size_t ws_size, hipStream_t stream) {
    unsigned char* ws = (unsigned char*)d_ws;
#if !MK_DEBUG
    mk_launch(d_in, (float*)d_out, ws, stream);
#else
    size_t off = al(F_END); float* alt = (float*)(ws + off); off += al((size_t)out_size * 4);
    double* acc = (double*)(ws + off); off += 4096;
    float* nws = (float*)(ws + off); size_t nused = 0; (void)nv::carve_ws(nws, nused); off += al(nused * 4);
    nv::Snap sn; const size_t MDf = (size_t)M * D;
    float* sp = (float*)(ws + off);
    sn.Z[0] = sp; sn.Z[1] = sp + MDf; sn.MIX[0] = sp + 2 * MDf; sn.MIX[1] = sp + 3 * MDf; sn.HA[0] = sp + 4 * MDf; sn.HA[1] = sp + 5 * MDf; sn.HD0 = sp + 6 * MDf; sn.KN = sp + 7 * MDf; sn.V = sn.KN + (size_t)M * TOKW;
    off += al((7 * MDf + 2 * (size_t)M * TOKW) * 4);
    float* ew = (float*)(ws + off); off += al((size_t)2 * FF * D * 4);
    if (off > ws_size) { fprintf(stderr, "debug layout needs %zu bytes, ws has %zu\n", off, ws_size); return; }
    nv::run(d_in, (float*)d_out, nws, stream, &sn);
    mk_launch(d_in, alt, ws, stream);
    (void)hipMemsetAsync(acc, 0, 4096, stream);
    OutPtrs A = carve_out(alt), R = carve_out((float*)d_out);
    int st = 0;
#define CMP(f, isb, ldf, n, ldn, rows, cols) do { hipLaunchKernelGGL(dbg::k_cmp, dim3(1024), dim3(256), 0, stream, (const void*)(f), (isb), (ldf), (const float*)(n), (ldn), (rows), (cols), acc, st); ++st; } while (0)
    const size_t MD2 = (size_t)M * D * 2;
#define WCHK(MAP, W, ldw, K, N, gain, cs, WT) do { hipLaunchKernelGGL(dbg::k_expw<MAP>, dim3(1024), dim3(256), 0, stream, (const float*)(W), (ldw), (K), (N), (const float*)(gain), (const float*)(cs), ew); CMP((WT), 1, (K), ew, (K), (N), (K)); } while (0)
    { const float* g_mix = (const float*)d_in[10]; const float* w_in = (const float*)d_in[11]; const float* w_out = (const float*)d_in[12]; const float* g_ffn = (const float*)d_in[13]; const float* w_gu = (const float*)d_in[14];
      const float* w_down = (const float*)d_in[15]; const float* w_pool = (const float*)d_in[20]; const float* pscale = (const float*)d_in[21]; const float* g_kv = (const float*)d_in[22]; const float* w_kv = (const float*)d_in[23];
      WCHK(MAP_ID, w_pool, 128, 128, 128, nullptr, pscale, ws + F_WPOOL);
      WCHK(MAP_ID, w_pool + 3 * 128 * 128, 128, 128, 128, nullptr, pscale + 3 * 128, ws + F_WPOOL + 3 * 128 * 128 * 2);
      WCHK(MAP_ID, w_out + (size_t)D * D, D, D, D, nullptr, nullptr, ws + F_WOUT + (size_t)D * D * 2);
      WCHK(MAP_SWIGLU, w_gu + (size_t)D * 2 * FF, 2 * FF, D, 2 * FF, g_ffn + D, nullptr, ws + F_WGU + (size_t)2 * FF * D * 2);
      WCHK(MAP_ID, w_down + (size_t)FF * D, D, FF, D, nullptr, nullptr, ws + F_WDOWN + (size_t)D * FF * 2);
      WCHK(MAP_HEAD64, w_kv, D, D, D, g_kv, nullptr, ws + F_W6);
      WCHK(MAP_HEAD64, w_in + (size_t)D * D, D, D, D, g_mix + D, nullptr, ws + F_W6 + (size_t)D * D * 2); }
    CMP(ws + F_ZB, 1, D, sn.Z[0], D, M, D);
    CMP(A.mv_p, 0, TOKW, R.mv_p, TOKW, 2 * MEMROWS, TOKW);
    CMP(A.mk_p, 0, TOKW, R.mk_p, TOKW, 2 * MEMROWS, TOKW);
    CMP(ws + F_MIXB, 1, D, sn.MIX[0], D, MP, 128);
    CMP(ws + F_MIXB + 128 * 2, 1, D, sn.MIX[0] + 128, D, MP, 384);
    CMP(ws + F_MIXB + (size_t)MP * D * 2, 1, D, sn.MIX[0] + (size_t)MP * D, D, MS, TOKW);
    CMP(ws + F_MIXB + TOKW * 2, 1, D, sn.MIX[0] + TOKW, D, MP, TOKW);
    CMP(ws + F_MIXB + (size_t)MP * D * 2 + TOKW * 2, 1, D, sn.MIX[0] + (size_t)MP * D + TOKW, D, MS, TOKW);
    CMP(A.ps_p, 0, TOKW, R.ps_p, TOKW, PB * 15, TOKW);
    CMP(A.ps_s, 0, TOKW, R.ps_s, TOKW, SB * 15, TOKW);
    CMP(ws + F_HB, 1, D, sn.HA[0], D, M, D);
    CMP(ws + F_HB + MD2, 1, D, sn.HD0, D, M, D);
    CMP(ws + F_KB, 1, TOKW, sn.KN, TOKW, M, TOKW);
    CMP(ws + F_VB, 1, TOKW, sn.V, TOKW, M, TOKW);
    CMP(A.k_p, 0, TOKW, R.k_p, TOKW, MP, TOKW);
    CMP(A.v_p, 0, TOKW, R.v_p, TOKW, MP, TOKW);
    CMP(A.k_s, 0, TOKW, R.k_s, TOKW, MS, TOKW);
    CMP(A.v_s, 0, TOKW, R.v_s, TOKW, MS, TOKW);
    CMP(A.lf_p, 0, 8, R.lf_p, 8, MP, 8);
    CMP(A.lf_s, 0, 8, R.lf_s, 8, MS, 8);
    CMP(ws + F_Z1B, 1, D, sn.Z[1], D, M, D);
    CMP(ws + F_MIXB + MD2, 1, D, sn.MIX[1], D, MP, TOKW);
    CMP(ws + F_MIXB + MD2 + (size_t)MP * D * 2, 1, D, sn.MIX[1] + (size_t)MP * D, D, MS, TOKW);
    CMP(ws + F_MIXB + MD2 + TOKW * 2, 1, D, sn.MIX[1] + TOKW, D, MP, TOKW);
    CMP(ws + F_MIXB + MD2 + (size_t)MP * D * 2 + TOKW * 2, 1, D, sn.MIX[1] + (size_t)MP * D + TOKW, D, MS, TOKW);
    CMP(ws + F_HB + MD2 * 2, 1, D, sn.HA[1], D, M, D);
    CMP(A.y_p, 0, D, R.y_p, D, MP, D);
    CMP(A.y_s, 0, D, R.y_s, D, MS, D);
#undef CMP
    hipLaunchKernelGGL(dbg::k_verdict, dim3(1), dim3(64), 0, stream, acc, st, (double)MK_DEBUG_TOL, (float*)d_out);
#endif
}
```
